# Optimizing an MI355X kernel written in HIP

```python
import jax, jax.numpy as jnp
from jax import lax
import numpy as np

D_MODEL = 1024
BATCH = 4
SEQ = 4096
DEPTH = 1

CHUNK = 64
Q_BLOCK = 128
N_HEADS = 8
Q_LORA = 256
KV_LORA = 128
QK_NOPE = 64
QK_ROPE = 32
V_HEAD = 64
QK_HEAD = QK_NOPE + QK_ROPE
ROPE_THETA = 10000.0
CONV_WIDTH = 512
CONV_K = 3
N_EXPERTS = 32
TOP_K = 4
D_EXPERT = 1024
SWIGLU_LIMIT = 7.0
SWIGLU_ALPHA = 1.702
MOE_BLOCK = 256
RMS_EPS = 1e-6
IN_SPLITS = (Q_LORA, KV_LORA, QK_ROPE, CONV_WIDTH, CONV_WIDTH, CONV_WIDTH, D_MODEL, D_MODEL)
IN_WIDTH = Q_LORA + KV_LORA + QK_ROPE + 3 * CONV_WIDTH + 2 * D_MODEL

kernel_name = 'hybrid_mla_shortconv_moe_adaln_block'


def rms_norm(x, g):
    xf = x.astype(jnp.float32)
    xf = xf * lax.rsqrt(jnp.mean(xf * xf, axis=-1, keepdims=True) + RMS_EPS)
    return xf.astype(x.dtype) * g


def rope_tables(positions, dtype):
    inv_freq = 1.0 / (ROPE_THETA ** (jnp.arange(0, QK_ROPE, 2, dtype=jnp.float32) / QK_ROPE))
    ang = positions.astype(jnp.float32)[..., None] * inv_freq
    return jnp.cos(ang).astype(dtype), jnp.sin(ang).astype(dtype)


def apply_rope(x, cos, sin):
    half = x.shape[-1] // 2
    x1, x2 = x[..., :half], x[..., half:]
    return jnp.concatenate([x1 * cos - x2 * sin, x1 * sin + x2 * cos], axis=-1)


def block_causal_attention(q, k, v):
    B, S, H, Dh = q.shape
    nqb = S // Q_BLOCK
    key_chunk = jnp.arange(S) // CHUNK
    scale = QK_HEAD ** -0.5
    qb = q.reshape(B, nqb, Q_BLOCK, H, Dh).transpose(1, 0, 2, 3, 4)

    def one_block(args):
        q_blk, i = args
        q_chunk = (i * Q_BLOCK + jnp.arange(Q_BLOCK)) // CHUNK
        allowed = key_chunk[None, :] <= q_chunk[:, None]
        s = jnp.einsum('bqhd,bkhd->bhqk', q_blk, k, preferred_element_type=jnp.float32) * scale
        s = jnp.where(allowed[None, None], s, -jnp.inf)
        p = jax.nn.softmax(s, axis=-1).astype(v.dtype)
        return jnp.einsum('bhqk,bkhd->bqhd', p, v)

    out = lax.map(one_block, (qb, jnp.arange(nqb)))
    return out.transpose(1, 0, 2, 3, 4).reshape(B, S, H, v.shape[-1])


def causal_depthwise_conv(z, w):
    C = z.shape[-1]
    return lax.conv_general_dilated(
        z, w[:, None, :].astype(z.dtype), window_strides=(1,), padding=((CONV_K - 1, 0),),
        dimension_numbers=('NWC', 'WIO', 'NWC'), feature_group_count=C)


def hybrid_mixer(h, cos, sin, w_in, q_norm_g, w_uq, kv_norm_g, w_ukv, w_up_attn, conv_w, w_up_conv, w_o):
    B, S, _ = h.shape
    proj = h @ w_in
    split_at = np.cumsum(IN_SPLITS)[:-1].tolist()
    q_lat, kv_lat, k_pe, u, c_gate, b_gate, g_attn, g_conv = jnp.split(proj, split_at, axis=-1)
    q = (rms_norm(q_lat, q_norm_g) @ w_uq).reshape(B, S, N_HEADS, QK_HEAD)
    q = jnp.concatenate([q[..., :QK_NOPE], apply_rope(q[..., QK_NOPE:], cos[:, :, None], sin[:, :, None])], axis=-1)
    kv = (rms_norm(kv_lat, kv_norm_g) @ w_ukv).reshape(B, S, N_HEADS, QK_NOPE + V_HEAD)
    k_nope, v = kv[..., :QK_NOPE], kv[..., QK_NOPE:]
    k_pe = apply_rope(k_pe, cos, sin)[:, :, None, :]
    k = jnp.concatenate([k_nope, jnp.broadcast_to(k_pe, (B, S, N_HEADS, QK_ROPE))], axis=-1)
    attn = block_causal_attention(q, k, v).reshape(B, S, N_HEADS * V_HEAD)
    a_branch = attn @ w_up_attn
    z = causal_depthwise_conv(c_gate * u, conv_w)
    c_branch = (b_gate * z) @ w_up_conv
    merged = jax.nn.sigmoid(g_attn) * a_branch + jax.nn.sigmoid(g_conv) * c_branch
    return merged @ w_o


def moe_ffn(h, router_w, router_b, w_gu, b_gu, w_down, b_down):
    T, D = h.shape
    logits = (h @ router_w + router_b).astype(jnp.float32)
    top_val, top_idx = lax.top_k(logits, TOP_K)
    gate_w = jax.nn.softmax(top_val, axis=-1)
    flat_e = top_idx.reshape(-1)
    flat_tok = jnp.arange(T * TOP_K, dtype=jnp.int32) // TOP_K
    flat_w = gate_w.reshape(-1)
    order = jnp.argsort(flat_e)
    sorted_e = flat_e[order]
    counts = jnp.bincount(flat_e, length=N_EXPERTS)
    padded = (counts + MOE_BLOCK - 1) // MOE_BLOCK * MOE_BLOCK
    pad_end = jnp.cumsum(padded)
    pad_start = pad_end - padded
    grp_start = jnp.cumsum(counts) - counts
    rank = jnp.arange(T * TOP_K) - grp_start[sorted_e]
    dest = pad_start[sorted_e] + rank
    n_rows = T * TOP_K + N_EXPERTS * MOE_BLOCK
    n_blocks = n_rows // MOE_BLOCK
    row_tok = jnp.zeros((n_rows,), jnp.int32).at[dest].set(flat_tok[order])
    row_w = jnp.zeros((n_rows,), jnp.float32).at[dest].set(flat_w[order])
    block_start = jnp.arange(n_blocks) * MOE_BLOCK
    block_expert = jnp.minimum(jnp.searchsorted(pad_end, block_start, side='right'), N_EXPERTS - 1)
    xs = h[row_tok].reshape(n_blocks, MOE_BLOCK, D)

    def expert_block(args):
        xb, e = args
        gu = xb @ w_gu[e] + b_gu[e]
        gate, up = gu[:, :D_EXPERT], gu[:, D_EXPERT:]
        gate = jnp.minimum(gate, SWIGLU_LIMIT)
        up = jnp.clip(up, -SWIGLU_LIMIT, SWIGLU_LIMIT)
        act = (up + 1.0) * (gate * jax.nn.sigmoid(gate * SWIGLU_ALPHA))
        return act @ w_down[e] + b_down[e]

    ys = lax.map(expert_block, (xs, block_expert)).reshape(n_rows, D)
    ys = ys * row_w[:, None].astype(h.dtype)
    return jax.ops.segment_sum(ys, row_tok, num_segments=T)


def setup_inputs(seed: int = 0) -> dict:
    key = jax.random.key(seed)
    ks = jax.random.split(key, 24)
    f32 = jnp.float32
    L, D = DEPTH, D_MODEL

    def nrm(k, shape, scale):
        return jax.random.normal(k, shape, f32) * scale

    x = jax.random.normal(ks[0], (BATCH, SEQ, D), f32)
    c = jax.random.normal(ks[1], (BATCH, D), f32)
    offsets = jax.random.randint(ks[2], (BATCH, 1), 0, 4096, dtype=jnp.int32)
    positions = offsets + jnp.arange(SEQ, dtype=jnp.int32)[None, :]
    return {
        'x': x,
        'c': c,
        'positions': positions,
        'w_ada': nrm(ks[3], (L, D, 6 * D), 0.5 * D ** -0.5),
        'b_ada': nrm(ks[4], (L, 6 * D), 0.01),
        'norm_mix_g': 1.0 + nrm(ks[5], (L, D), 0.05),
        'w_in': nrm(ks[6], (L, D, IN_WIDTH), D ** -0.5),
        'q_norm_g': 1.0 + nrm(ks[7], (L, Q_LORA), 0.05),
        'w_uq': nrm(ks[8], (L, Q_LORA, N_HEADS * QK_HEAD), Q_LORA ** -0.5),
        'kv_norm_g': 1.0 + nrm(ks[9], (L, KV_LORA), 0.05),
        'w_ukv': nrm(ks[10], (L, KV_LORA, N_HEADS * (QK_NOPE + V_HEAD)), KV_LORA ** -0.5),
        'w_up_attn': nrm(ks[11], (L, N_HEADS * V_HEAD, D), (N_HEADS * V_HEAD) ** -0.5),
        'conv_w': nrm(ks[12], (L, CONV_K, CONV_WIDTH), CONV_K ** -0.5),
        'w_up_conv': nrm(ks[13], (L, CONV_WIDTH, D), CONV_WIDTH ** -0.5),
        'w_o': nrm(ks[14], (L, D, D), D ** -0.5),
        'norm_ffn_g': 1.0 + nrm(ks[15], (L, D), 0.05),
        'router_w': nrm(ks[16], (L, D, N_EXPERTS), D ** -0.5),
        'router_b': nrm(ks[17], (L, N_EXPERTS), 0.01),
        'w_gu': nrm(ks[18], (L, N_EXPERTS, D, 2 * D_EXPERT), D ** -0.5),
        'b_gu': nrm(ks[19], (L, N_EXPERTS, 2 * D_EXPERT), 0.01),
        'w_down': nrm(ks[20], (L, N_EXPERTS, D_EXPERT, D), D_EXPERT ** -0.5),
        'b_down': nrm(ks[21], (L, N_EXPERTS, D), 0.01),
        'norm_final_g': 1.0 + nrm(ks[22], (D,), 0.05),
    }


def reference(x, c, positions, w_ada, b_ada, norm_mix_g, w_in, q_norm_g, w_uq, kv_norm_g, w_ukv,
              w_up_attn, conv_w, w_up_conv, w_o, norm_ffn_g, router_w, router_b, w_gu, b_gu,
              w_down, b_down, norm_final_g):
    B, S, D = x.shape
    cos, sin = rope_tables(positions, x.dtype)
    c_act = jax.nn.silu(c)
    for l in range(DEPTH):
        ada = (c_act @ w_ada[l] + b_ada[l])[:, None, :]
        sh_m, sc_m, g_m, sh_f, sc_f, g_f = jnp.split(ada, 6, axis=-1)
        h = rms_norm(x, norm_mix_g[l]) * (1.0 + sc_m) + sh_m
        mix = hybrid_mixer(h, cos, sin, w_in[l], q_norm_g[l], w_uq[l], kv_norm_g[l], w_ukv[l],
                           w_up_attn[l], conv_w[l], w_up_conv[l], w_o[l])
        x = x + g_m * mix
        h = rms_norm(x, norm_ffn_g[l]) * (1.0 + sc_f) + sh_f
        ffn = moe_ffn(h.reshape(B * S, D), router_w[l], router_b[l], w_gu[l], b_gu[l], w_down[l], b_down[l])
        x = x + g_f * ffn.reshape(B, S, D)
    return rms_norm(x, norm_final_g)
```

```cpp
#include <hip/hip_runtime.h>
#include <cstdio>
#include <cstdint>

#define LAS __attribute__((address_space(3)))
#define GAS __attribute__((address_space(1)))
typedef unsigned short bf16_t;
typedef short bf16x8 __attribute__((ext_vector_type(8)));
typedef float f32x4 __attribute__((ext_vector_type(4)));
typedef float f32x16 __attribute__((ext_vector_type(16)));
typedef unsigned u32x4 __attribute__((ext_vector_type(4)));
typedef unsigned u32x2 __attribute__((ext_vector_type(2)));
typedef int v8i __attribute__((ext_vector_type(8)));
typedef int v8i_a16 __attribute__((ext_vector_type(8), aligned(16)));

#ifndef MK_N_LAUNCHES
#define MK_N_LAUNCHES 1
#endif
#ifndef FAST_P2
#define FAST_P2 1
#endif
#ifndef FAST_P4
#define FAST_P4 1
#endif
#ifndef FAST_P6
#define FAST_P6 1
#endif
#ifndef FAST_P7
#define FAST_P7 1
#endif
#ifndef FAST_P9
#define FAST_P9 1
#endif
#ifndef FAST_P10
#define FAST_P10 1
#endif
#ifndef MOE_FP8
#define MOE_FP8 1
#endif
constexpr float W8S = MOE_FP8 ? 0.015625f : 1.0f;
constexpr int ME = MOE_FP8 ? 1 : 2;
#ifndef Y_FP8
#define Y_FP8 1
#endif
#ifndef FAST_ATTN
#define FAST_ATTN 1
#endif
constexpr int NPHASE = 12;
constexpr int NWAVES = 8, NTHREADS = 512;

constexpr int T = 16384, D = 1024, SEQ = 4096, NH = 8;
constexpr int INW = 4000, NIN = 4096;
constexpr int NE = 32, ECAP = 16384;
constexpr float RMS_EPS = 1e-6f;
constexpr float ATT_SCALE = 0.10206207261596575f;
#if FAST_ATTN
constexpr float QSCALE = ATT_SCALE * 1.4426950408889634f;
#else
constexpr float QSCALE = 1.0f;
#endif

constexpr size_t MiB = 1u << 20;
constexpr size_t WS_CTL = 0, CTL_ZERO_BYTES = 64 * 1024;
constexpr size_t WS_ADAP = 1 * MiB, WS_ADA = 3 * MiB, WS_RSTDQ = 4 * MiB, WS_RSTDKV = 4 * MiB + 512 * 1024, WS_CS = 5 * MiB, WS_SN = 6 * MiB, WS_GW = 7 * MiB, WS_RFLAT = 8 * MiB;
constexpr size_t WS_WIN = 10 * MiB, WS_WUP = 18 * MiB, WS_WA = 19 * MiB, WS_WC = 20 * MiB, WS_WO = 21 * MiB, WS_WGU = 24 * MiB, WS_WD = 152 * MiB;
constexpr size_t WS_H = 216 * MiB, WS_LAT = 248 * MiB, WS_VC = 264 * MiB, WS_BG = 280 * MiB, WS_SG = 296 * MiB, WS_BZ = 360 * MiB;
constexpr size_t WS_Q = 376 * MiB, WS_K = 400 * MiB, WS_V = 432 * MiB, WS_O = 448 * MiB, WS_TMP = 464 * MiB, WS_MRG = 496 * MiB;
constexpr size_t WS_OB = WS_TMP;
constexpr size_t WS_X1 = WS_O;
constexpr size_t WS_ACT = 528 * MiB, WS_Y = 672 * MiB, WS_END = 800 * MiB;
constexpr int CW_BAR = 4096, CW_CNT = 8192;

constexpr int RING_BYTES = 131072;
constexpr int LDS_TAB = 131072, TAB_UNITS = 12;
constexpr int LDS_MOE = LDS_TAB + TAB_UNITS * 1024;
constexpr int LDS_BYTES = 155648;
constexpr int LDS_MISC = LDS_BYTES - 256;
static_assert(LDS_MISC + 128 <= LDS_BYTES && LDS_MOE + 512 <= LDS_MISC, "LDS map");

__device__ __forceinline__ float bf_lo(unsigned w) { return __uint_as_float(w << 16); }
__device__ __forceinline__ float bf_hi(unsigned w) { return __uint_as_float(w & 0xffff0000u); }
__device__ __forceinline__ unsigned cvt_pk_bf16(float lo, float hi) { unsigned r; asm volatile("v_cvt_pk_bf16_f32 %0, %1, %2" : "=v"(r) : "v"(lo), "v"(hi)); return r; }
__device__ __forceinline__ u32x4 pack8(f32x4 a, f32x4 b) { u32x4 w; w.x = cvt_pk_bf16(a[0], a[1]); w.y = cvt_pk_bf16(a[2], a[3]); w.z = cvt_pk_bf16(b[0], b[1]); w.w = cvt_pk_bf16(b[2], b[3]); return w; }
__device__ __forceinline__ unsigned pack4_fp8(f32x4 a) { int w = __builtin_amdgcn_cvt_pk_fp8_f32(a[0], a[1], 0, false); return (unsigned)__builtin_amdgcn_cvt_pk_fp8_f32(a[2], a[3], w, true); }
__device__ __forceinline__ u32x2 pack8_fp8(f32x4 a, f32x4 b) { u32x2 w; w.x = pack4_fp8(a); w.y = pack4_fp8(b); return w; }
__device__ __forceinline__ u32x2 pack4(f32x4 a) { u32x2 w; w.x = cvt_pk_bf16(a[0], a[1]); w.y = cvt_pk_bf16(a[2], a[3]); return w; }
__device__ __forceinline__ void unpack8(u32x4 w, float* f) { f[0] = bf_lo(w.x); f[1] = bf_hi(w.x); f[2] = bf_lo(w.y); f[3] = bf_hi(w.y); f[4] = bf_lo(w.z); f[5] = bf_hi(w.z); f[6] = bf_lo(w.w); f[7] = bf_hi(w.w); }
__device__ __forceinline__ float wave_sum(float v) {
#pragma unroll
    for (int o = 1; o < 64; o <<= 1) v += __shfl_xor(v, o);
    return v;
}
__device__ __forceinline__ u32x2 pack8_u8(f32x4 a, f32x4 b) { unsigned w0 = 0, w1 = 0;
    w0 = __builtin_amdgcn_cvt_pk_u8_f32(fmaxf(a[0] * 255.0f, 1.0f), 0, w0); w0 = __builtin_amdgcn_cvt_pk_u8_f32(fmaxf(a[1] * 255.0f, 1.0f), 1, w0);
    w0 = __builtin_amdgcn_cvt_pk_u8_f32(fmaxf(a[2] * 255.0f, 1.0f), 2, w0); w0 = __builtin_amdgcn_cvt_pk_u8_f32(fmaxf(a[3] * 255.0f, 1.0f), 3, w0);
    w1 = __builtin_amdgcn_cvt_pk_u8_f32(fmaxf(b[0] * 255.0f, 1.0f), 0, w1); w1 = __builtin_amdgcn_cvt_pk_u8_f32(fmaxf(b[1] * 255.0f, 1.0f), 1, w1);
    w1 = __builtin_amdgcn_cvt_pk_u8_f32(fmaxf(b[2] * 255.0f, 1.0f), 2, w1); w1 = __builtin_amdgcn_cvt_pk_u8_f32(fmaxf(b[3] * 255.0f, 1.0f), 3, w1);
    return (u32x2){w0, w1}; }
__device__ __forceinline__ void unpack8_u8(u32x2 w, float* f) {
    f[0] = (float)(w.x & 0xffu); f[1] = (float)((w.x >> 8) & 0xffu); f[2] = (float)((w.x >> 16) & 0xffu); f[3] = (float)(w.x >> 24);
    f[4] = (float)(w.y & 0xffu); f[5] = (float)((w.y >> 8) & 0xffu); f[6] = (float)((w.y >> 16) & 0xffu); f[7] = (float)(w.y >> 24); }
__device__ __forceinline__ float fast_sigmoid(float x) { return __builtin_amdgcn_rcpf(1.0f + __builtin_amdgcn_exp2f(-1.4426950408889634f * x)); }
#define LDS_WAIT() asm volatile("s_waitcnt lgkmcnt(0)" ::: "memory")
#define VM_WAIT() asm volatile("s_waitcnt vmcnt(0)" ::: "memory")

#define XB_TMO      128
#define XB_XCNT(j)  (256  + 64 * (j))
#define XB_XSUB(j)  (1280 + 64 * (j))
#define XB_XGEN(j)  (2304 + 64 * (j))
#define XB_TOP      3328
#define XB_TOPGEN   3392
#define XCD_BAR_WORDS 3456
#define XB_SPIN_CAP (1u << 22)
__device__ __forceinline__ unsigned xb_ld(unsigned* p)              { return __hip_atomic_load(p, __ATOMIC_RELAXED, __HIP_MEMORY_SCOPE_AGENT); }
__device__ __forceinline__ unsigned xb_add(unsigned* p, unsigned v) { return __hip_atomic_fetch_add(p, v, __ATOMIC_RELAXED, __HIP_MEMORY_SCOPE_AGENT); }
__device__ __forceinline__ unsigned xb_xcc_id() { return (unsigned)__builtin_amdgcn_s_getreg((3 << 11) | 20) & 0xFu; }
#define XB_SPIN(cond, bar) do { unsigned _sp = 0; while (cond) { __builtin_amdgcn_s_sleep(1); \
    if ((++_sp & 255u) == 0u) { if (xb_ld(&(bar)[XB_TMO])) break; if (_sp > XB_SPIN_CAP) { atomicAdd(&(bar)[XB_TMO], 1u); break; } } } } while (0)
struct XcdBarrier { unsigned* bar; unsigned x; volatile LAS unsigned* st; };
__device__ __forceinline__ XcdBarrier xcd_barrier_post(unsigned* bar, volatile LAS unsigned* st) {
    XcdBarrier b; b.bar = bar; b.x = xb_xcc_id(); b.st = st;
    if (threadIdx.x == 0) (void)xb_add(&bar[XB_XCNT(b.x)], 1u);
    return b;
}
__device__ __forceinline__ void xcd_barrier_complete(unsigned* bar, unsigned x, unsigned& nloc, unsigned& nx) {
    const unsigned G = gridDim.x * gridDim.y * gridDim.z;
    unsigned sum, cnt, mine, sp = 0u;
    for (;;) {
        sum = 0u; cnt = 0u; mine = 0u;
#pragma unroll
        for (unsigned j = 0; j < 16; ++j) { const unsigned c = xb_ld(&bar[XB_XCNT(j)]); sum += c; cnt += (c > 0u) ? 1u : 0u; mine = (j == x) ? c : mine; }
        if (sum == G) break;
        __builtin_amdgcn_s_sleep(1);
        if ((++sp & 255u) == 0u) { if (xb_ld(&bar[XB_TMO])) break; if (sp > XB_SPIN_CAP) { atomicAdd(&bar[XB_TMO], 1u); break; } }
    }
    nloc = mine > 0u ? mine : 1u; nx = cnt > 0u ? cnt : 1u;
}
__device__ __forceinline__ void xcd_barrier(const XcdBarrier& b) {
    asm volatile("s_waitcnt vmcnt(0)" ::: "memory");
    __syncthreads();
    if (threadIdx.x == 0) {
        unsigned* bar = b.bar;
        __builtin_amdgcn_s_waitcnt(0);
        unsigned nloc = b.st[0], nx = b.st[1];
        if (nloc == 0u) { xcd_barrier_complete(bar, b.x, nloc, nx); b.st[0] = nloc; b.st[1] = nx; }
        const unsigned old = xb_add(&bar[XB_XSUB(b.x)], 1u);
        const unsigned gen = old / nloc;
        if (old + 1u == (gen + 1u) * nloc) {
            __builtin_amdgcn_fence(__ATOMIC_RELEASE, "agent");
            asm volatile("s_waitcnt vmcnt(0)" ::: "memory");
            const unsigned og = xb_add(&bar[XB_TOP], 1u);
            const unsigned tg = og / nx;
            if (og + 1u == (tg + 1u) * nx) xb_add(&bar[XB_TOPGEN], 1u);
            else XB_SPIN(xb_ld(&bar[XB_TOPGEN]) == tg, bar);
            __builtin_amdgcn_fence(__ATOMIC_ACQUIRE, "agent");
            xb_add(&bar[XB_XGEN(b.x)], 1u);
            asm volatile("s_waitcnt vmcnt(0)" ::: "memory");
        } else {
            XB_SPIN(xb_ld(&bar[XB_XGEN(b.x)]) == gen, bar);
            __builtin_amdgcn_fence(__ATOMIC_ACQUIRE, "agent");
            asm volatile("s_waitcnt vmcnt(0)" ::: "memory");
        }
    }
    __syncthreads();
}

namespace ge {
constexpr int BM = 256, BK = 64, HALF = 128, HTB = HALF * BK * 2, NXCD = 8, WGM = 8;
__host__ __device__ __forceinline__ int lds_byte(int r, int c) { const int st = (r >> 4) * 2 + (c >> 5), rr = r & 15, cc = c & 31, ob = rr * 64 + cc * 2; return st * 1024 + (ob ^ (((ob >> 9) & 1) << 5)); }
__host__ __device__ __forceinline__ void stage_rc(int b, int& R, int& C) { const int st = b / 1024, sb = b % 1024, swz = sb ^ (((sb >> 9) & 1) << 5); R = (st >> 1) * 16 + swz / 64; C = (st & 1) * 32 + (swz % 64) / 2; }
__host__ __device__ __forceinline__ int lds_byte8(int r, int cb) { const int st = (r >> 4) * 2 + (cb >> 6), ob = (r & 15) * 64 + (cb & 63); return st * 1024 + (ob ^ (((ob >> 9) & 1) << 4)); }
__host__ __device__ __forceinline__ void stage_rc8(int b, int& R, int& Cb) { const int st = b / 1024, sb = b % 1024, swz = sb ^ (((sb >> 9) & 1) << 4); R = (st >> 1) * 16 + swz / 64; Cb = (st & 1) * 64 + (swz % 64); }
__host__ __device__ __forceinline__ int perm32(int rho) { const int n = rho >> 4, i = rho & 15; return 8 * (i >> 2) + 4 * n + (i & 3); }

struct Unit { int pm, pn, e, aux; };
struct Gemm { const char* A; const char* B; int lda, ldb, kb; };
constexpr int SC_W8 = 0x79797979, SC_A8 = 0x7f7f7f7f;

__device__ __forceinline__ int xcd_remap(int L, int nwg) { const int q = nwg / NXCD, r = nwg % NXCD, xcd = L % NXCD, off = L / NXCD; return (xcd < r ? xcd * (q + 1) : r * (q + 1) + (xcd - r) * q) + off; }

struct DenseSched {
    int nM, nN, nwg, G, c, lda, ldb, ksplit, akofs;
    __device__ __forceinline__ void init(int M, int N, int G_, int c_, int lda_, int ldb_, int ksplit_ = 1 << 30, int akofs_ = 0) { nM = M / BM; nN = N / BM; nwg = nM * nN; G = G_; c = c_; lda = lda_; ldb = ldb_; ksplit = ksplit_; akofs = akofs_; }
    __device__ __forceinline__ bool next(int i, Unit& u) const {
        const long L = (long)i * G + c; if (L >= nwg) return false;
        const int wgid = xcd_remap((int)L, nwg);
        const int nig = WGM * nN, gid = wgid / nig, fm = gid * WGM, gsz = (nM - fm) < WGM ? (nM - fm) : WGM;
        u.pm = fm + ((wgid % nig) % gsz); u.pn = (wgid % nig) / gsz; u.e = 0; u.aux = 0; return true;
    }
    __device__ __forceinline__ size_t a_off(const Unit& u) const { return (size_t)u.pm * BM * lda + (u.pn >= ksplit ? akofs : 0); }
    __device__ __forceinline__ size_t b_off(const Unit& u) const { return (size_t)u.pn * BM * ldb; }
    __device__ __forceinline__ unsigned a_rowoff(const Unit&, int, int r) const { return (unsigned)r * (unsigned)lda; }
};
struct MoeSched {
    const LAS int* tb; const LAS unsigned* tab; int nN, ntiles, G, c, lda, ldb, nper; bool gather;
    __device__ __forceinline__ bool next(int i, Unit& u) const {
        const int nwg = ntiles * nN; const long L = (long)i * G + c; if (L >= nwg) return false;
        const int wgid = xcd_remap((int)L, nwg);
        const int tile = wgid / nN; int e = 0; while (e < NE - 1 && tile >= __builtin_amdgcn_readfirstlane(tb[e + 1])) ++e;
        u.pm = tile; u.pn = wgid % nN; u.e = e; u.aux = tile - __builtin_amdgcn_readfirstlane(tb[e]); return true;
    }
    __device__ __forceinline__ size_t a_off(const Unit& u) const { return gather ? (size_t)0 : (size_t)u.pm * BM * lda; }
    __device__ __forceinline__ size_t b_off(const Unit& u) const { return ((size_t)u.e * nper + (size_t)u.pn * BM) * ldb; }
    __device__ __forceinline__ unsigned a_rowoff(const Unit&, int ui, int r) const { return gather ? tab[ui * 256 + r] : (unsigned)r * (unsigned)lda; }
};

template <bool FP8> __device__ __forceinline__ void ref_ld4(const char* p, float* f, float sc) {
    if constexpr (FP8) { const int w = *(const int*)p; f[0] = __builtin_amdgcn_cvt_f32_fp8(w, 0) * sc; f[1] = __builtin_amdgcn_cvt_f32_fp8(w, 1) * sc; f[2] = __builtin_amdgcn_cvt_f32_fp8(w, 2) * sc; f[3] = __builtin_amdgcn_cvt_f32_fp8(w, 3) * sc; }
    else { const u32x2 w = *(const u32x2*)p; f[0] = bf_lo(w.x) * sc; f[1] = bf_hi(w.x) * sc; f[2] = bf_lo(w.y) * sc; f[3] = bf_hi(w.y) * sc; }
}
template <int AI, bool FP8, class Epi, class Sched>
__device__ __forceinline__ void ref_half(const Gemm& g, const Sched& S, const Epi& E, const Unit& u, int ui, const char* Ab, const char* Bb, int wr, int wc, int fr, int fq) {
    constexpr int ES = FP8 ? 1 : 2;
    f32x4 acc[2][2][4][2];
#pragma unroll
    for (int a = 0; a < 2; ++a)
#pragma unroll
        for (int b = 0; b < 2; ++b)
#pragma unroll
            for (int m = 0; m < 4; ++m)
#pragma unroll
                for (int n = 0; n < 2; ++n) acc[a][b][m][n] = (f32x4){0.f, 0.f, 0.f, 0.f};
    unsigned aoff[4];
#pragma unroll
    for (int m = 0; m < 4; ++m) aoff[m] = S.a_rowoff(u, ui, AI * HALF + wr * 64 + m * 16 + fr);
    for (int khalf = 0; khalf < 2; ++khalf) {
    if constexpr (Epi::HAS_MID) { if (khalf == 1) E.template mid<AI, AI + 1>(acc, u, wr, wc, fr, fq); }
#pragma unroll
    for (int bj = 0; bj < 2; ++bj)
#pragma unroll
        for (int n = 0; n < 2; ++n) {
            const char* Bc = Bb + (size_t)(bj * HALF + wc * 32 + (Epi::PERM ? 8 * fq + 4 * n : 16 * n + 4 * fq)) * g.ldb;
            for (int kbyte = khalf * (g.kb / 2); kbyte < (khalf + 1) * (g.kb / 2); kbyte += 4 * ES) {
                float af[4][4];
#pragma unroll
                for (int r = 0; r < 4; ++r) ref_ld4<FP8>(Ab + aoff[r] + kbyte, af[r], 1.0f);
#pragma unroll
                for (int i = 0; i < 4; ++i) {
                    float bf[4]; ref_ld4<FP8>(Bc + (size_t)i * g.ldb + kbyte, bf, 1.0f);
#pragma unroll
                    for (int m = 0; m < 4; ++m) { float s = acc[AI][bj][m][n][i];
                        s = fmaf(af[m][0], bf[0], s); s = fmaf(af[m][1], bf[1], s); s = fmaf(af[m][2], bf[2], s); s = fmaf(af[m][3], bf[3], s);
                        acc[AI][bj][m][n][i] = s; }
                }
            }
        }
    }
    E.template run<AI, AI + 1>(acc, u, wr, wc, fr, fq);
}
template <class Epi, class Sched, bool FP8>
__device__ __forceinline__ void gemm_phase_ref(const Gemm g, const Sched& S, const Epi& E) {
    const int tid = threadIdx.x, wid = tid >> 6, lane = tid & 63, wr = wid >> 2, wc = wid & 3, fr = lane & 15, fq = lane >> 4;
    Unit u;
    for (int ui = 0; S.next(ui, u); ++ui) {
        const char* Ab = g.A + S.a_off(u); const char* Bb = g.B + S.b_off(u);
        ref_half<0, FP8, Epi, Sched>(g, S, E, u, ui, Ab, Bb, wr, wc, fr, fq);
        ref_half<1, FP8, Epi, Sched>(g, S, E, u, ui, Ab, Bb, wr, wc, fr, fq);
    }
}

template <class Epi, class Sched, bool GATHER, bool FP8>
__device__ __forceinline__ void gemm_phase_fast(LAS unsigned char* lds, const Gemm g, const Sched& S, const Epi& E) {
    const int tid = threadIdx.x, wid = __builtin_amdgcn_readfirstlane(tid >> 6), lane = tid & 63, wr = wid >> 2, wc = wid & 3, fr = lane & 15, fq = lane >> 4;
    const int nt = g.kb / 128;
    unsigned voffA[2], voffB[2]; int RA[2], CA2[2];
#pragma unroll
    for (int i = 0; i < 2; ++i) { int R, C2;
        if constexpr (FP8) stage_rc8(tid * 16 + i * 8192, R, C2); else { int C; stage_rc(tid * 16 + i * 8192, R, C); C2 = C * 2; }
        const int Rb = Epi::PERM ? ((R & ~31) + perm32(R & 31)) : R;
        voffA[i] = (unsigned)(R * g.lda + C2); voffB[i] = (unsigned)(Rb * g.ldb + C2); RA[i] = R; CA2[i] = C2; }
    const size_t kstep = (size_t)(BK * 2);
    const size_t hstepA = (size_t)HALF * g.lda, hstepB = (size_t)HALF * g.ldb;
    const unsigned ldsw = (unsigned)wid * 1024u;
    const int aoff = FP8 ? lds_byte8(wr * 64 + fr, fq * 32) : lds_byte(wr * 64 + fr, fq * 8), boff = FP8 ? lds_byte8(wc * 32 + fr, fq * 32) : lds_byte(wc * 32 + fr, fq * 8);
    const int aoff2 = aoff ^ 16, boff2 = boff ^ 16;
#define PG8_SA(b, h) (((b) * 2 + (h)) * HTB)
#define PG8_SB(b, h) ((4 + (b) * 2 + (h)) * HTB)
#define PG8_GLDS(src, bufoff, i_) __builtin_amdgcn_global_load_lds((const unsigned*)(src), (LAS unsigned*)(lds + (bufoff) + ldsw + (i_) * 8192), 16, 0, 0)
#define PG8_STAGE_B(bufoff, p, h) do { _Pragma("unroll") for (int _i = 0; _i < 2; ++_i) PG8_GLDS((const char*)(p) + (h) * hstepB + voffB[_i], bufoff, _i); } while (0)
#define PG8_STAGE_A(bufoff, p, h, NX) do { _Pragma("unroll") for (int _i = 0; _i < 2; ++_i) { \
        if constexpr (GATHER) PG8_GLDS((const char*)(p) + ((NX) ? gvN[h][_i] : gvC[h][_i]), bufoff, _i); \
        else PG8_GLDS((const char*)(p) + (h) * hstepA + voffA[_i], bufoff, _i); } } while (0)
#define PG8_LDA(dst, b, h) do { _Pragma("unroll") for (int m = 0; m < 4; ++m) { \
        if constexpr (FP8) { const u32x4 lo_ = *(const LAS u32x4*)(lds + PG8_SA(b, h) + aoff + m * 2048), hi_ = *(const LAS u32x4*)(lds + PG8_SA(b, h) + aoff2 + m * 2048); \
            dst##8[m] = (v8i){(int)lo_.x, (int)lo_.y, (int)lo_.z, (int)lo_.w, (int)hi_.x, (int)hi_.y, (int)hi_.z, (int)hi_.w}; } \
        else { _Pragma("unroll") for (int k = 0; k < 2; ++k) dst[m][k] = *(const LAS bf16x8*)(lds + PG8_SA(b, h) + aoff + m * 2048 + k * 1024); } } } while (0)
#define PG8_LDB(dst, b, h) do { _Pragma("unroll") for (int n = 0; n < 2; ++n) { \
        if constexpr (FP8) { const u32x4 lo_ = *(const LAS u32x4*)(lds + PG8_SB(b, h) + boff + n * 2048), hi_ = *(const LAS u32x4*)(lds + PG8_SB(b, h) + boff2 + n * 2048); \
            dst##8[n] = (v8i){(int)lo_.x, (int)lo_.y, (int)lo_.z, (int)lo_.w, (int)hi_.x, (int)hi_.y, (int)hi_.z, (int)hi_.w}; } \
        else { _Pragma("unroll") for (int k = 0; k < 2; ++k) dst[n][k] = *(const LAS bf16x8*)(lds + PG8_SB(b, h) + boff + n * 2048 + k * 1024); } } } while (0)
#define PG8_MMA(ai, bj, At, Bt) do { __builtin_amdgcn_s_setprio(1); _Pragma("unroll") for (int m = 0; m < 4; ++m) _Pragma("unroll") for (int n = 0; n < 2; ++n) { \
        if constexpr (FP8) asm volatile("v_mfma_f32_16x16x128_f8f6f4 %0, %1, %2, %0" : "+v"(acc[ai][bj][m][n]) : "v"(Bt##8[n]), "v"(At##8[m])); \
        else { _Pragma("unroll") for (int k = 0; k < 2; ++k) acc[ai][bj][m][n] = __builtin_amdgcn_mfma_f32_16x16x32_bf16(Bt[n][k], At[m][k], acc[ai][bj][m][n], 0, 0, 0); } } \
        __builtin_amdgcn_s_setprio(0); } while (0)
#define PG8_WAIT_V(n) asm volatile("s_waitcnt vmcnt(" #n ")" ::: "memory")
#define PG8_WAIT_L(n) asm volatile("s_waitcnt lgkmcnt(" #n ")" ::: "memory")
#define PG8_BAR __builtin_amdgcn_s_barrier()
#define PG8_SCHED __builtin_amdgcn_sched_barrier(0)
    Unit cur, nxt; int ui = 0;
    if (!S.next(0, cur)) return;
    f32x4 acc[2][2][4][2];
#pragma unroll
    for (int a = 0; a < 2; ++a)
#pragma unroll
        for (int b = 0; b < 2; ++b)
#pragma unroll
            for (int m = 0; m < 4; ++m)
#pragma unroll
                for (int n = 0; n < 2; ++n) acc[a][b][m][n] = (f32x4){0.f, 0.f, 0.f, 0.f};
    bf16x8 At[4][2], B0[2][2], B1[2][2]; v8i At8[4], B08[2], B18[2];
    unsigned gvC[2][2], gvN[2][2];
#pragma unroll
    for (int h = 0; h < 2; ++h)
#pragma unroll
        for (int i = 0; i < 2; ++i) { gvC[h][i] = GATHER ? S.a_rowoff(cur, 0, h * HALF + RA[i]) + (unsigned)CA2[i] : 0u; gvN[h][i] = gvC[h][i]; }
    const char* cA = g.A + S.a_off(cur); const char* cB = g.B + S.b_off(cur);
    PG8_STAGE_B(PG8_SB(0, 0), cB, 0); PG8_STAGE_B(PG8_SB(0, 1), cB, 1); PG8_STAGE_A(PG8_SA(0, 0), cA, 0, false); PG8_STAGE_A(PG8_SA(0, 1), cA, 1, false);
    if (wr == 1) PG8_BAR;
    PG8_WAIT_V(2); PG8_BAR;
    PG8_STAGE_B(PG8_SB(1, 0), cB + kstep, 0); PG8_STAGE_A(PG8_SA(1, 0), cA + kstep, 0, false); PG8_STAGE_B(PG8_SB(1, 1), cB + kstep, 1);
    PG8_WAIT_V(6); PG8_BAR;
    for (;;) {
        const bool has_next = S.next(ui + 1, nxt);
        const char* nA = has_next ? g.A + S.a_off(nxt) : cA; const char* nB = has_next ? g.B + S.b_off(nxt) : cB;
        if constexpr (GATHER) { if (has_next) {
#pragma unroll
            for (int h = 0; h < 2; ++h)
#pragma unroll
                for (int i = 0; i < 2; ++i) gvN[h][i] = S.a_rowoff(nxt, ui + 1, h * HALF + RA[i]) + (unsigned)CA2[i]; } }
#pragma unroll 1
        for (int t = 0; t < nt; t += 2) {
            if constexpr (Epi::HAS_MID) { if (t * 2 == nt) { int fr_ = fr, fq_ = fq; asm volatile("" : "+v"(fr_), "+v"(fq_)); E.template mid<0, 2>(acc, cur, wr, wc, fr_, fq_); } }
            asm volatile("" : "+v"(voffA[0]), "+v"(voffA[1]), "+v"(voffB[0]), "+v"(voffB[1]));
            const bool last = (t == nt - 2);
            const char* a1 = cA + (size_t)(t + 1) * kstep;
            const char* a2 = last ? nA : cA + (size_t)(t + 2) * kstep; const char* b2 = last ? nB : cB + (size_t)(t + 2) * kstep;
            const char* a3 = a2 + kstep; const char* b3 = b2 + kstep;
            PG8_LDB(B0, 0, 0); PG8_LDB(B1, 0, 1); PG8_SCHED; PG8_LDA(At, 0, 0); PG8_STAGE_A(PG8_SA(1, 1), a1, 1, false);
            PG8_WAIT_V(8); PG8_WAIT_L(0); PG8_BAR; PG8_MMA(0, 0, At, B0); PG8_MMA(0, 1, At, B1); PG8_BAR; PG8_SCHED;
            PG8_LDA(At, 0, 1); PG8_STAGE_B(PG8_SB(0, 0), b2, 0); PG8_STAGE_B(PG8_SB(0, 1), b2, 1); PG8_STAGE_A(PG8_SA(0, 0), a2, 0, last);
            PG8_WAIT_V(8); PG8_WAIT_L(0); PG8_BAR; PG8_MMA(1, 0, At, B0); PG8_MMA(1, 1, At, B1); PG8_BAR; PG8_SCHED;
            PG8_LDB(B0, 1, 0); PG8_LDB(B1, 1, 1); PG8_SCHED; PG8_LDA(At, 1, 0); PG8_STAGE_A(PG8_SA(0, 1), a2, 1, last);
            PG8_WAIT_V(8); PG8_WAIT_L(0); PG8_BAR; PG8_MMA(0, 0, At, B0); PG8_MMA(0, 1, At, B1); PG8_BAR; PG8_SCHED;
            PG8_LDA(At, 1, 1); PG8_STAGE_B(PG8_SB(1, 0), b3, 0); PG8_STAGE_B(PG8_SB(1, 1), b3, 1); PG8_STAGE_A(PG8_SA(1, 0), a3, 0, last);
            PG8_WAIT_V(8); PG8_WAIT_L(0); PG8_BAR; PG8_MMA(1, 0, At, B0); PG8_MMA(1, 1, At, B1); PG8_BAR; PG8_SCHED;
        }
        if (wr == 0) PG8_BAR;
        if constexpr (FP8) asm volatile("s_nop 15\n\ts_nop 7" ::: "memory");
        { int fr_ = fr, fq_ = fq; asm volatile("" : "+v"(fr_), "+v"(fq_));
          E.template run<0, 2>(acc, cur, wr, wc, fr_, fq_); }
        if (!has_next) break;
#pragma unroll
        for (int a = 0; a < 2; ++a)
#pragma unroll
            for (int b = 0; b < 2; ++b)
#pragma unroll
                for (int m = 0; m < 4; ++m)
#pragma unroll
                    for (int n = 0; n < 2; ++n) acc[a][b][m][n] = (f32x4){0.f, 0.f, 0.f, 0.f};
        cur = nxt; cA = nA; cB = nB; ++ui;
        if constexpr (GATHER) {
#pragma unroll
            for (int h = 0; h < 2; ++h)
#pragma unroll
                for (int i = 0; i < 2; ++i) gvC[h][i] = gvN[h][i]; }
        if (wr == 1) PG8_BAR;
    }
    PG8_WAIT_V(0);
    PG8_BAR;
#undef PG8_SA
#undef PG8_SB
#undef PG8_GLDS
#undef PG8_STAGE_A
#undef PG8_STAGE_B
#undef PG8_LDA
#undef PG8_LDB
#undef PG8_MMA
#undef PG8_WAIT_V
#undef PG8_WAIT_L
#undef PG8_BAR
#undef PG8_SCHED
}
}

using ge::Unit;
#define EPI_ROW(ai, m) ((ai) * 128 + wr * 64 + (m) * 16 + fr)
struct EpiInProj {
    static constexpr bool PERM = true, HAS_MID = false;
    bf16_t *LAT, *VC, *BG, *SG;
    float *RSQ, *RSKV; const float *CS, *SN; bf16_t* K; LAS float* red;
    template <int A0, int A1> __device__ __forceinline__ void run(const f32x4 (&acc)[2][2][4][2], const Unit& u, int wr, int wc, int fr, int fq) const {
        const int pn = u.pn;
        if constexpr (A0 == 0 && A1 == 2) { if (pn < 2) {
            const int t_ = threadIdx.x;
            if (t_ < 256) red[t_] = 0.f;
            asm volatile("s_waitcnt lgkmcnt(0)" ::: "memory"); __builtin_amdgcn_s_barrier(); asm volatile("" ::: "memory");
#pragma unroll
            for (int ai = 0; ai < 2; ++ai)
#pragma unroll
                for (int m = 0; m < 4; ++m) { float ps = 0.f;
#pragma unroll
                    for (int n = 0; n < 2; ++n)
#pragma unroll
                        for (int i = 0; i < 4; ++i) { const float v0 = acc[ai][0][m][n][i], v1 = acc[ai][1][m][n][i]; ps += v0 * v0 + (pn == 0 ? v1 * v1 : 0.f); }
                    ps += __shfl_xor(ps, 16); ps += __shfl_xor(ps, 32);
                    if (fq == 0) __hip_atomic_fetch_add(red + EPI_ROW(ai, m), ps, __ATOMIC_RELAXED, __HIP_MEMORY_SCOPE_WORKGROUP); }
            asm volatile("s_waitcnt lgkmcnt(0)" ::: "memory"); __builtin_amdgcn_s_barrier(); asm volatile("" ::: "memory");
            if (t_ < 256) { const float s_ = red[t_]; if (pn == 0) RSQ[(size_t)u.pm * 256 + t_] = 1.0f / sqrtf(s_ * (1.0f / 256.0f) + RMS_EPS); else RSKV[(size_t)u.pm * 256 + t_] = 1.0f / sqrtf(s_ * (1.0f / 128.0f) + RMS_EPS); }
            if (pn == 1 && wc == 0) {
#pragma unroll
                for (int ai = 0; ai < 2; ++ai)
#pragma unroll
                    for (int m = 0; m < 4; ++m) { const size_t row = (size_t)u.pm * 256 + EPI_ROW(ai, m); const int j0 = 8 * (fq & 1);
                        f32x4 o2[2];
#pragma unroll
                        for (int n = 0; n < 2; ++n) { const f32x4 cs = *(const f32x4*)(CS + row * 16 + j0 + 4 * n), sn = *(const f32x4*)(SN + row * 16 + j0 + 4 * n);
#pragma unroll
                            for (int i = 0; i < 4; ++i) { const float v = acc[ai][1][m][n][i], oth = __shfl_xor(v, 32); o2[n][i] = fq < 2 ? v * cs[i] - oth * sn[i] : oth * sn[i] + v * cs[i]; } }
                        const u32x4 w = pack8(o2[0], o2[1]);
#pragma unroll
                        for (int h = 0; h < NH; ++h) *(u32x4*)(K + row * 1024 + h * 128 + 64 + 8 * fq) = w; }
            }
        } }
#pragma unroll
        for (int ai = A0; ai < A1; ++ai)
#pragma unroll
            for (int m = 0; m < 4; ++m) {
                const size_t row = (size_t)u.pm * 256 + EPI_ROW(ai, m);
                if (pn >= 2 && pn < 6) {
                    const int lc = wc * 32 + 8 * fq;
                    *(u32x4*)(VC + row * 512 + 128 * (pn - 2) + lc) = pack8(acc[ai][0][m][0] * acc[ai][1][m][0], acc[ai][0][m][1] * acc[ai][1][m][1]);
                } else {
#pragma unroll
                    for (int bj = 0; bj < 2; ++bj) {
                        const int lc = bj * 128 + wc * 32 + 8 * fq; const f32x4 v0 = acc[ai][bj][m][0], v1 = acc[ai][bj][m][1];
                        if (pn < 2) *(u32x4*)(LAT + row * 512 + 256 * pn + lc) = pack8(v0, v1);
                        else if (pn < 8) *(u32x4*)(BG + row * 512 + 256 * (pn - 6) + lc) = pack8(v0, v1);
                        else { f32x4 s0, s1;
#pragma unroll
                            for (int i = 0; i < 4; ++i) { s0[i] = fast_sigmoid(v0[i]); s1[i] = fast_sigmoid(v1[i]); }
                            *(u32x2*)((unsigned char*)SG + row * 2048 + 256 * (pn - 8) + lc) = pack8_u8(s0, s1); }
                    }
                }
            }
    }
};
struct EpiUp {
    static constexpr bool PERM = false, HAS_MID = false;
    bf16_t *Q, *K, *V; const float *RSQ, *RSKV, *CS, *SN;
    template <int A0, int A1> __device__ __forceinline__ void run(const f32x4 (&acc)[2][2][4][2], const Unit& u, int wr, int wc, int fr, int fq) const {
        const int pn = u.pn;
#pragma unroll
        for (int ai = A0; ai < A1; ++ai)
#pragma unroll
            for (int m = 0; m < 4; ++m) {
                const size_t row = (size_t)u.pm * 256 + EPI_ROW(ai, m);
                if (pn < 3) {
                    const float rs = RSQ[row];
#pragma unroll
                    for (int bj = 0; bj < 2; ++bj) {
                        const int grp = 8 * pn + 4 * bj + wc; const int lc = 256 * pn + bj * 128 + wc * 32 + 4 * fq;
                        f32x4 x1 = acc[ai][bj][m][0] * rs, x2 = acc[ai][bj][m][1] * rs;
                        if (grp % 3 == 2) { const f32x4 cs = *(const f32x4*)(CS + row * 16 + 4 * fq), sn = *(const f32x4*)(SN + row * 16 + 4 * fq);
                            const f32x4 o1 = x1 * cs - x2 * sn, o2 = x1 * sn + x2 * cs; x1 = o1; x2 = o2; }
                        x1 = x1 * QSCALE; x2 = x2 * QSCALE;
                        *(u32x2*)(Q + row * 768 + lc) = pack4(x1); *(u32x2*)(Q + row * 768 + lc + 16) = pack4(x2);
                    }
                } else {
                    const float rs = RSKV[row];
#pragma unroll
                    for (int bj = 0; bj < 2; ++bj)
#pragma unroll
                        for (int n = 0; n < 2; ++n) {
                            const int lc = bj * 128 + wc * 32 + 16 * n + 4 * fq; const f32x4 v = acc[ai][bj][m][n] * rs;
                            if (pn < 5) { const int c = 256 * (pn - 3) + lc; *(u32x2*)(K + row * 1024 + (c >> 6) * 128 + (c & 63)) = pack4(v); }
                            else *(u32x2*)(V + row * 512 + 256 * (pn - 5) + lc) = pack4(v);
                        }
                }
            }
    }
};
template <int STEP> struct EpiBranch {
    static constexpr bool PERM = true, HAS_MID = false;
    const bf16_t* SG; bf16_t* TMP; bf16_t* MRG;
    template <int A0, int A1> __device__ __forceinline__ void run(const f32x4 (&acc)[2][2][4][2], const Unit& u, int wr, int wc, int fr, int fq) const {
#pragma unroll
        for (int ai = A0; ai < A1; ++ai)
#pragma unroll
            for (int m = 0; m < 4; ++m) {
                const size_t row = (size_t)u.pm * 256 + EPI_ROW(ai, m);
#pragma unroll
                for (int bj = 0; bj < 2; ++bj) {
                    const int col = 256 * u.pn + bj * 128 + wc * 32 + 8 * fq;
                    float sg[8]; unpack8(*(const u32x4*)(SG + row * 2048 + (STEP ? 1024 : 0) + col), sg);
                    f32x4 r0, r1;
#pragma unroll
                    for (int i = 0; i < 4; ++i) { r0[i] = sg[i] * acc[ai][bj][m][0][i]; r1[i] = sg[4 + i] * acc[ai][bj][m][1][i]; }
                    if (STEP == 0) *(u32x4*)(TMP + row * 1024 + col) = pack8(r0, r1);
                    else { float t[8]; unpack8(*(const u32x4*)(TMP + row * 1024 + col), t);
#pragma unroll
                        for (int i = 0; i < 4; ++i) { r0[i] += t[i]; r1[i] += t[4 + i]; }
                        *(u32x4*)(MRG + row * 1024 + col) = pack8(r0, r1); }
                }
            }
    }
};
struct EpiMerged {
    static constexpr bool PERM = true, HAS_MID = true;
    const bf16_t* SG; bf16_t* MRG;
    template <int A0, int A1> __device__ __forceinline__ void mid(f32x4 (&acc)[2][2][4][2], const Unit& u, int wr, int wc, int fr, int fq) const {
#pragma unroll
        for (int ai = A0; ai < A1; ++ai)
#pragma unroll
            for (int m = 0; m < 4; ++m) {
                const size_t row = (size_t)u.pm * 256 + EPI_ROW(ai, m);
#pragma unroll
                for (int bj = 0; bj < 2; ++bj) {
                    const int col = 256 * u.pn + bj * 128 + wc * 32 + 8 * fq;
                    float sa[8], sc[8]; unpack8_u8(*(const u32x2*)((const unsigned char*)SG + row * 2048 + col), sa); unpack8_u8(*(const u32x2*)((const unsigned char*)SG + row * 2048 + 1024 + col), sc);
#pragma unroll
                    for (int i = 0; i < 4; ++i) { acc[ai][bj][m][0][i] *= sa[i] * __builtin_amdgcn_rcpf(sc[i]); acc[ai][bj][m][1][i] *= sa[4 + i] * __builtin_amdgcn_rcpf(sc[4 + i]); }
                }
            }
    }
    template <int A0, int A1> __device__ __forceinline__ void run(const f32x4 (&acc)[2][2][4][2], const Unit& u, int wr, int wc, int fr, int fq) const {
#pragma unroll
        for (int ai = A0; ai < A1; ++ai)
#pragma unroll
            for (int m = 0; m < 4; ++m) {
                const size_t row = (size_t)u.pm * 256 + EPI_ROW(ai, m);
#pragma unroll
                for (int bj = 0; bj < 2; ++bj) {
                    const int col = 256 * u.pn + bj * 128 + wc * 32 + 8 * fq;
                    float sc[8]; unpack8_u8(*(const u32x2*)((const unsigned char*)SG + row * 2048 + 1024 + col), sc);
                    f32x4 r0, r1;
#pragma unroll
                    for (int i = 0; i < 4; ++i) { r0[i] = (sc[i] * (1.0f / 255.0f)) * acc[ai][bj][m][0][i]; r1[i] = (sc[4 + i] * (1.0f / 255.0f)) * acc[ai][bj][m][1][i]; }
                    *(u32x4*)(MRG + row * 1024 + col) = pack8(r0, r1);
                }
            }
    }
};
struct EpiWo {
    static constexpr bool PERM = false, HAS_MID = false;
    const float* X; const float* ADA; bf16_t* X1;
    template <int A0, int A1> __device__ __forceinline__ void run(const f32x4 (&acc)[2][2][4][2], const Unit& u, int wr, int wc, int fr, int fq) const {
#pragma unroll
        for (int ai = A0; ai < A1; ++ai)
#pragma unroll
            for (int m = 0; m < 4; ++m) {
                const size_t row = (size_t)u.pm * 256 + EPI_ROW(ai, m); const int b = (int)(row >> 12);
#pragma unroll
                for (int bj = 0; bj < 2; ++bj)
#pragma unroll
                    for (int n = 0; n < 2; ++n) {
                        const int col = 256 * u.pn + bj * 128 + wc * 32 + 16 * n + 4 * fq;
                        const f32x4 xv = *(const f32x4*)(X + row * 1024 + col), gm = *(const f32x4*)(ADA + b * 6144 + 2048 + col);
                        *(u32x2*)(X1 + row * 1024 + col) = pack4(xv + gm * acc[ai][bj][m][n]);
                    }
            }
    }
};
struct EpiGU {
    static constexpr bool PERM = true, HAS_MID = false;
    const float* BGU; unsigned char* ACT;
    template <int A0, int A1> __device__ __forceinline__ void run(const f32x4 (&acc)[2][2][4][2], const Unit& u, int wr, int wc, int fr, int fq) const {
        const int col = 128 * u.pn + wc * 32 + 8 * fq;
        f32x4 bg[2], bu[2];
#pragma unroll
        for (int n = 0; n < 2; ++n) { bg[n] = *(const f32x4*)(BGU + (size_t)u.e * 2048 + col + 4 * n); bu[n] = *(const f32x4*)(BGU + (size_t)u.e * 2048 + 1024 + col + 4 * n); }
#pragma unroll
        for (int ai = A0; ai < A1; ++ai)
#pragma unroll
            for (int m = 0; m < 4; ++m) {
                const size_t row = (size_t)u.pm * 256 + EPI_ROW(ai, m);
                f32x4 r[2];
#pragma unroll
                for (int n = 0; n < 2; ++n)
#pragma unroll
                    for (int i = 0; i < 4; i += 2) {
                        typedef float f32x2 __attribute__((ext_vector_type(2)));
                        f32x2 gt = (f32x2){acc[ai][0][m][n][i], acc[ai][0][m][n][i + 1]} * W8S + (f32x2){bg[n][i], bg[n][i + 1]};
                        f32x2 up = (f32x2){acc[ai][1][m][n][i], acc[ai][1][m][n][i + 1]} * W8S + (f32x2){bu[n][i], bu[n][i + 1]};
                        gt = __builtin_elementwise_min(gt, (f32x2){7.0f, 7.0f});
                        up = __builtin_elementwise_min(__builtin_elementwise_max(up, (f32x2){-7.0f, -7.0f}), (f32x2){7.0f, 7.0f});
                        const f32x2 t = gt * (-1.702f * 1.4426950408889634f);
                        f32x2 d; d.x = __builtin_amdgcn_exp2f(t.x); d.y = __builtin_amdgcn_exp2f(t.y); d = d + 1.0f;
                        f32x2 q; q.x = __builtin_amdgcn_rcpf(d.x); q.y = __builtin_amdgcn_rcpf(d.y);
                        const f32x2 sg = gt * q, res = up * sg + sg;
                        r[n][i] = res.x; r[n][i + 1] = res.y;
                    }
                if (MOE_FP8) *(u32x2*)(ACT + row * 1024 + col) = pack8_fp8(r[0], r[1]);
                else *(u32x4*)(ACT + (row * 1024 + col) * 2) = pack8(r[0], r[1]);
            }
    }
};
struct EpiDown {
    static constexpr bool PERM = true, HAS_MID = false;
    const float* BD; const int* RFLAT; const LAS int* CNT; unsigned char* Y;
    template <int A0, int A1> __device__ __forceinline__ void run(const f32x4 (&acc)[2][2][4][2], const Unit& u, int wr, int wc, int fr, int fq) const {
        const int cnt = CNT[u.e];
        f32x4 bv[2][2];
#pragma unroll
        for (int bj = 0; bj < 2; ++bj)
#pragma unroll
            for (int n = 0; n < 2; ++n) bv[bj][n] = *(const f32x4*)(BD + (size_t)u.e * 1024 + 256 * u.pn + bj * 128 + wc * 32 + 8 * fq + 4 * n);
#pragma unroll
        for (int ai = A0; ai < A1; ++ai)
#pragma unroll
            for (int m = 0; m < 4; ++m) {
                const int rr = u.aux * 256 + EPI_ROW(ai, m);
                if (rr < cnt) {
                    const size_t f = (size_t)RFLAT[(size_t)u.e * ECAP + rr];
#pragma unroll
                    for (int bj = 0; bj < 2; ++bj) {
                        const int col = 256 * u.pn + bj * 128 + wc * 32 + 8 * fq;
                        const f32x4 y0 = acc[ai][bj][m][0] * W8S + bv[bj][0], y1 = acc[ai][bj][m][1] * W8S + bv[bj][1];
                        if (Y_FP8) *(u32x2*)(Y + f * 1024 + col) = pack8_fp8(y0 * 16.0f, y1 * 16.0f); else *(u32x4*)(Y + (f * 1024 + col) * 2) = pack8(y0, y1);
                    }
                }
            }
    }
};

template <bool FAST, bool GATHER, bool FP8, class Epi, class Sched>
__device__ __forceinline__ void run_gemm(LAS unsigned char* lds, const ge::Gemm g, const Sched& S, const Epi& E) {
    if constexpr (FAST) ge::gemm_phase_fast<Epi, Sched, GATHER, FP8>(lds, g, S, E);
    else ge::gemm_phase_ref<Epi, Sched, FP8>(g, S, E);
}

struct Args { const void* in[23]; float* out; unsigned char* ws; int ph_lo, ph_hi, li, pad; };
typedef const __attribute__((address_space(4))) unsigned char* kptr_t;
struct KA { kptr_t kp; unsigned char* ws; float* out;
    __device__ __forceinline__ const void* in(int i) const { return *(const void* const volatile __attribute__((address_space(4)))*)(kp + 8 * i); } };
enum { I_X = 0, I_C, I_POS, I_WADA, I_BADA, I_GMIX, I_WIN, I_GQ, I_WUQ, I_GKV, I_WUKV, I_WA, I_CONVW, I_WC, I_WO, I_GFFN, I_RW, I_RB, I_WGU, I_BGU, I_WD, I_BD, I_GFIN };

template <bool FP8> __device__ __forceinline__ void p0_item(const float* W, int N, int k0, int n0, bf16_t* WT, int ldk, int drow0, const float* gsc, LAS float* scr, int lane) {
#pragma unroll 8
    for (int i = 0; i < 32; ++i) { const int kk = 2 * i + (lane >> 5); scr[kk * 33 + (lane & 31)] = W[(size_t)(k0 + kk) * N + n0 + (lane & 31)]; }
    LDS_WAIT(); asm volatile("" ::: "memory");
    const int c = lane & 7;
    float gs[8];
#pragma unroll
    for (int t = 0; t < 8; ++t) gs[t] = gsc ? gsc[k0 + 8 * c + t] : 1.0f;
#pragma unroll
    for (int j = 0; j < 4; ++j) { const int n = (lane >> 3) + 8 * j; const LAS float* s = scr + (8 * c) * 33 + n;
        u32x4 o; o.x = cvt_pk_bf16(s[0 * 33] * gs[0], s[1 * 33] * gs[1]); o.y = cvt_pk_bf16(s[2 * 33] * gs[2], s[3 * 33] * gs[3]);
        o.z = cvt_pk_bf16(s[4 * 33] * gs[4], s[5 * 33] * gs[5]); o.w = cvt_pk_bf16(s[6 * 33] * gs[6], s[7 * 33] * gs[7]);
        if constexpr (FP8) { f32x4 a = {s[0 * 33], s[1 * 33], s[2 * 33], s[3 * 33]}, b = {s[4 * 33], s[5 * 33], s[6 * 33], s[7 * 33]};
            *(u32x2*)((unsigned char*)WT + (size_t)(drow0 + n) * ldk + k0 + 8 * c) = pack8_fp8(a * 64.0f, b * 64.0f); }
        else *(u32x4*)(WT + (size_t)(drow0 + n) * ldk + k0 + 8 * c) = o; }
    LDS_WAIT(); asm volatile("" ::: "memory");
}
struct BigItem { const float* W; int N, k0, n0, dA, dB; unsigned char* WT8; };
__device__ __forceinline__ BigItem big_item(const KA& a, int it) {
    BigItem b; const int e = it / 96, r = it % 96;
    if (r < 64) { const int kb = r >> 3, nb = r & 7, n0 = 256 * nb;
        b.W = (const float*)a.in(I_WGU) + (size_t)e * 1024 * 2048; b.N = 2048; b.k0 = 128 * kb; b.n0 = n0; b.WT8 = a.ws + WS_WGU + (size_t)e * 2048 * 1024;
        b.dA = n0 < 1024 ? (n0 >> 7) * 256 : ((n0 - 1024) >> 7) * 256 + 128; b.dB = n0 < 1024 ? ((n0 >> 7) + 1) * 256 : (((n0 - 1024) >> 7) + 1) * 256 + 128; }
    else { const int q = r - 64, kb = q >> 2, nb = q & 3;
        b.W = (const float*)a.in(I_WD) + (size_t)e * 1024 * 1024; b.N = 1024; b.k0 = 128 * kb; b.n0 = 256 * nb; b.WT8 = a.ws + WS_WD + (size_t)e * 1024 * 1024; b.dA = 256 * nb; b.dB = 256 * nb + 128; }
    return b;
}
constexpr int CONV_IN_ITEMS = 2048, CONV_SLICES = 4 * CONV_IN_ITEMS;
__device__ __forceinline__ void glds16_nt(const void* gsrc, unsigned lds_dst) {
    unsigned keep;
    asm volatile("s_mov_b32 %0, m0\n\ts_mov_b32 m0, %2\n\ts_nop 0\n\tglobal_load_lds_dwordx4 %1, off nt\n\ts_mov_b32 m0, %0" : "=&s"(keep) : "v"(gsrc), "s"(lds_dst) : "memory");
}
struct ConvCtx { int c, r, s0, ns; };
constexpr int CONV_SLOT = 32 * 1040;
#define CONV_DMA() do { const bool on_ = cx.c < cx.ns; const int sl_ = cx.s0 + cx.c; const BigItem cs_ = big_item(a, on_ ? sl_ >> 2 : 0);   \
        const float* p_ = cs_.W + (on_ ? (size_t)(cs_.k0 + 32 * (sl_ & 3) + wid) * cs_.N + cs_.n0 : (size_t)0) + 4 * lane; const size_t st_ = on_ ? (size_t)8 * cs_.N : (size_t)0; \
        LAS unsigned char* d_ = Cs + (cx.c & 1) * CONV_SLOT + wid * 1040; \
        _Pragma("unroll") for (int i = 0; i < 4; ++i) glds16_nt(p_ + i * st_, (unsigned)(uintptr_t)(d_ + i * 8 * 1040)); ++cx.c; } while (0)
#define CONV_TREAD(lag) do { if (cx.r + (lag) < cx.c && cx.r < cx.ns) { const int sl_ = cx.s0 + cx.r; const BigItem cs_ = big_item(a, sl_ >> 2); const int n_ = tid & 255, kh_ = tid >> 8; \
        const int drow_ = (n_ < 128 ? cs_.dA : cs_.dB) + (n_ & 127); const LAS float* sp_ = (const LAS float*)(Cs + (cx.r & 1) * CONV_SLOT) + (16 * kh_) * 260 + n_; u32x4 o_; \
        _Pragma("unroll") for (int h = 0; h < 4; ++h) { const f32x4 x_ = {sp_[(4 * h) * 260], sp_[(4 * h + 1) * 260], sp_[(4 * h + 2) * 260], sp_[(4 * h + 3) * 260]}; o_[h] = pack4_fp8(x_ * 64.0f); } \
        *(u32x4*)(cs_.WT8 + (size_t)drow_ * 1024 + cs_.k0 + 32 * (sl_ & 3) + 16 * kh_) = o_; ++cx.r; } } while (0)
__device__ __forceinline__ void expert_weight_share(const KA& a, LAS unsigned char* lds) {
    int tid = threadIdx.x; asm volatile("" : "+v"(tid));
    const int lane = tid & 63, w = __builtin_amdgcn_readfirstlane(tid >> 6);
    constexpr int NIT = 32 * 96, HB = 64 * 1040;
    const int G = (int)gridDim.x, bx = (int)blockIdx.x;
    const int NHF = CONV_IN_ITEMS + bx < NIT ? 2 * ((NIT - CONV_IN_ITEMS - bx + G - 1) / G) : 0;
#define DMA_ISSUE(h_) do { const BigItem b_ = big_item(a, CONV_IN_ITEMS + bx + ((h_) >> 1) * G); const float* src_ = b_.W + (size_t)(b_.k0 + 64 * ((h_) & 1) + w) * b_.N + b_.n0 + 4 * lane; \
        LAS unsigned char* dst_ = lds + ((h_) & 1) * HB + w * 1040; \
        _Pragma("unroll") for (int i = 0; i < 8; ++i) __builtin_amdgcn_global_load_lds((const unsigned*)(src_ + (size_t)(8 * i) * b_.N), (LAS unsigned*)(dst_ + i * 8 * 1040), 16, 0, 2); } while (0)
    if (NHF > 0) DMA_ISSUE(0);
#pragma unroll 1
    for (int h = 0; h < NHF; ++h) {
        if (h + 1 < NHF) { DMA_ISSUE(h + 1); asm volatile("s_waitcnt vmcnt(8)" ::: "memory"); } else asm volatile("s_waitcnt vmcnt(0)" ::: "memory");
        __builtin_amdgcn_s_barrier();
        { const BigItem b = big_item(a, CONV_IN_ITEMS + bx + (h >> 1) * G); const int n = tid & 255, kh = tid >> 8; const int drow = (n < 128 ? b.dA : b.dB) + (n & 127);
          const LAS float* sp = (const LAS float*)(lds + (h & 1) * HB) + (32 * kh) * 260 + n;
          unsigned char* dst = b.WT8 + (size_t)drow * 1024 + b.k0 + 64 * (h & 1) + 32 * kh;
#pragma unroll
          for (int q = 0; q < 2; ++q) { u32x4 o;
#pragma unroll
              for (int hh = 0; hh < 4; ++hh) { const LAS float* s4 = sp + (16 * q + 4 * hh) * 260; const f32x4 x = {s4[0], s4[260], s4[520], s4[780]}; o[hh] = pack4_fp8(x * 64.0f); }
              *(u32x4*)(dst + 16 * q) = o; } }
        asm volatile("s_waitcnt lgkmcnt(0)" ::: "memory");
        __builtin_amdgcn_s_barrier();
    }
#undef DMA_ISSUE
    __syncthreads();
}
__device__ __forceinline__ int map_in(int n0) {
    if (n0 < 416) return n0;
    if (n0 < 928) { const int j = n0 - 416; return 512 + (j >> 7) * 256 + (j & 127); }
    if (n0 < 1440) { const int j = n0 - 928; return 512 + (j >> 7) * 256 + 128 + (j & 127); }
    if (n0 < 1952) return 1536 + (n0 - 1440);
    if (n0 < 2976) return 2048 + (n0 - 1952);
    return 3072 + (n0 - 2976);
}
__device__ __forceinline__ void phase0(const KA& a, LAS unsigned char* lds, int gw, int NGW, int wave, int lane) {
    unsigned char* ws = a.ws;
    LAS float* scr = (LAS float*)(lds + wave * 16384);
    constexpr int I0 = 16 * 125, I1 = 4 * 24, I2 = 2 * 32, I3 = 8 * 32, I4 = 8 * 32, I5 = 16 * 32, I6 = MOE_FP8 ? 0 : 32 * 16 * 64, I7 = MOE_FP8 ? 0 : 32 * 16 * 32;
    constexpr int NIT = I0 + I1 + I2 + I3 + I4 + I5 + I6 + I7;
    for (int it = gw; it < NIT; it += NGW) {
        int r = it;
        if (r < I0) { const int kb = r / 125, nb = r % 125; p0_item<false>((const float*)a.in(I_WIN), INW, 64 * kb, 32 * nb, (bf16_t*)(ws + WS_WIN), 1024, map_in(32 * nb), nullptr, scr, lane); continue; } r -= I0;
        if (r < I1) { const int kb = r / 24, nb = r % 24; p0_item<false>((const float*)a.in(I_WUQ), 768, 64 * kb, 32 * nb, (bf16_t*)(ws + WS_WUP), 256, 32 * nb, (const float*)a.in(I_GQ), scr, lane); continue; } r -= I1;
        if (r < I2) { const int kb = r / 32, nb = r % 32, n0 = 32 * nb, h = n0 >> 7, j = n0 & 127; const int drow = 768 + (j < 64 ? 64 * h + j : 512 + 64 * h + (j - 64));
            p0_item<false>((const float*)a.in(I_WUKV), 1024, 64 * kb, n0, (bf16_t*)(ws + WS_WUP), 256, drow, (const float*)a.in(I_GKV), scr, lane); continue; } r -= I2;
        if (r < I3) { const int kb = r / 32, nb = r % 32; p0_item<false>((const float*)a.in(I_WA), 1024, 64 * kb, 32 * nb, (bf16_t*)(ws + WS_WA), 1024, 32 * nb, nullptr, scr, lane); continue; } r -= I3;
        if (r < I4) { const int kb = r / 32, nb = r % 32; p0_item<false>((const float*)a.in(I_WC), 1024, 64 * kb, 32 * nb, (bf16_t*)(ws + WS_WA) + 512, 1024, 32 * nb, nullptr, scr, lane); continue; } r -= I4;
        if (r < I5) { const int kb = r / 32, nb = r % 32; p0_item<false>((const float*)a.in(I_WO), 1024, 64 * kb, 32 * nb, (bf16_t*)(ws + WS_WO), 1024, 32 * nb, nullptr, scr, lane); continue; } r -= I5;
        if (r < I6) { const int e = r / 1024, q = r % 1024, kb = q / 64, nb = q % 64, n0 = 32 * nb; const int drow = n0 < 1024 ? (n0 >> 7) * 256 + (n0 & 127) : ((n0 - 1024) >> 7) * 256 + 128 + ((n0 - 1024) & 127);
            p0_item<MOE_FP8 != 0>((const float*)a.in(I_WGU) + (size_t)e * 1024 * 2048, 2048, 64 * kb, n0, (bf16_t*)(ws + WS_WGU + (size_t)e * 2048 * 1024 * ME), 1024, drow, nullptr, scr, lane); continue; } r -= I6;
        if (I7) { const int e = r / 512, q = r % 512, kb = q / 32, nb = q % 32;
            p0_item<MOE_FP8 != 0>((const float*)a.in(I_WD) + (size_t)e * 1024 * 1024, 1024, 64 * kb, 32 * nb, (bf16_t*)(ws + WS_WD + (size_t)e * 1024 * 1024 * ME), 1024, 32 * nb, nullptr, scr, lane); }
    }
    { const int gt = gw * 64 + lane, NGT = NGW * 64; const u32x4 z = {0u, 0u, 0u, 0u};
        for (int i = gt; i < 96 * 128; i += NGT) *(u32x4*)((bf16_t*)(ws + WS_WIN) + (size_t)416 * 1024 + (size_t)i * 8) = z;
        for (int i = gt; i < 1024 * 16; i += NGT) { const int row = 768 + (i >> 4), ch = i & 15; *(u32x4*)((bf16_t*)(ws + WS_WUP) + (size_t)row * 256 + 128 + ch * 8) = z; } }
    { const float* cc = (const float*)a.in(I_C); const float* wa = (const float*)a.in(I_WADA); float* adap = (float*)(ws + WS_ADAP);
        for (int t = gw; t < 96 * 16; t += NGW) { const int cg = t % 96, ks = t / 96;
            float sc[4], acc[4] = {0.f, 0.f, 0.f, 0.f};
#pragma unroll
            for (int b = 0; b < 4; ++b) { const float v = cc[b * 1024 + ks * 64 + lane]; sc[b] = v / (1.0f + expf(-v)); }
#pragma unroll 8
            for (int kk = 0; kk < 64; ++kk) { const float w = wa[(size_t)(ks * 64 + kk) * 6144 + cg * 64 + lane];
#pragma unroll
                for (int b = 0; b < 4; ++b) acc[b] = fmaf(__shfl(sc[b], kk), w, acc[b]); }
#pragma unroll
            for (int b = 0; b < 4; ++b) adap[(size_t)(ks * 4 + b) * 6144 + cg * 64 + lane] = acc[b]; } }
}

__device__ __forceinline__ void phase1(const KA& a, LAS unsigned char* lds, int tid, int wave, int lane) {
    unsigned char* ws = a.ws; const float* adap = (const float*)(ws + WS_ADAP); const float* bada = (const float*)a.in(I_BADA); float* ada = (float*)(ws + WS_ADA);
    for (int j = blockIdx.x * NTHREADS + tid; j < 4 * 6144; j += gridDim.x * NTHREADS) { const int b = j / 6144, n = j % 6144; float s = bada[n];
        for (int ks = 0; ks < 16; ++ks) s += adap[(size_t)(ks * 4 + b) * 6144 + n];
        ada[j] = s; }
    LAS float* al = (LAS float*)lds; LAS float* shl = al + 1024;
    const float* gmix = (const float*)a.in(I_GMIX); const float* X = (const float*)a.in(I_X); bf16_t* H = (bf16_t*)(ws + WS_H);
    const int* pos = (const int*)a.in(I_POS); float* CSt = (float*)(ws + WS_CS); float* SNt = (float*)(ws + WS_SN);
    for (int rb = blockIdx.x; rb < T / 64; rb += gridDim.x) {
        const int b = rb / 64;
        __syncthreads();
        for (int n = tid; n < 1024; n += NTHREADS) { float sh = bada[n], sc = bada[1024 + n];
            for (int ks = 0; ks < 16; ++ks) { sh += adap[(size_t)(ks * 4 + b) * 6144 + n]; sc += adap[(size_t)(ks * 4 + b) * 6144 + 1024 + n]; }
            al[n] = gmix[n] * (1.0f + sc); shl[n] = sh; }
        __syncthreads();
        for (int r = wave; r < 64; r += NWAVES) { const size_t row = (size_t)rb * 64 + r;
            f32x4 v[4]; float s = 0.f;
#pragma unroll
            for (int j = 0; j < 4; ++j) { v[j] = *(const f32x4*)(X + row * 1024 + 4 * lane + 256 * j); s += (v[j][0] * v[j][0] + v[j][1] * v[j][1]) + (v[j][2] * v[j][2] + v[j][3] * v[j][3]); }
            const float rstd = 1.0f / sqrtf(wave_sum(s) * (1.0f / 1024.0f) + RMS_EPS);
#pragma unroll
            for (int j = 0; j < 4; ++j) { const int c0 = 4 * lane + 256 * j; const f32x4 av = *(const LAS f32x4*)(al + c0), sv = *(const LAS f32x4*)(shl + c0);
                *(u32x2*)(H + row * 1024 + c0) = pack4(v[j] * rstd * av + sv); }
            if (lane < 16) { const float ang = (float)pos[row] * exp2f(-(float)lane * (13.287712379549449f / 16.0f)); float sn, cs; sincosf(ang, &sn, &cs);
                CSt[row * 16 + lane] = cs; SNt[row * 16 + lane] = sn; }
        }
    }
}

__device__ __forceinline__ void conv_rows(const KA& a, int blk0, int blk1, int first, int step, int lane) {
    unsigned char* ws = a.ws; const bf16_t* VC = (const bf16_t*)(ws + WS_VC); const bf16_t* BG = (const bf16_t*)(ws + WS_BG); bf16_t* BZ = (bf16_t*)(ws + WS_OB) + 512;
    const float* cw = (const float*)a.in(I_CONVW);
    float w0[8], w1[8], w2[8];
#pragma unroll
    for (int t = 0; t < 8; ++t) { w0[t] = cw[8 * lane + t]; w1[t] = cw[512 + 8 * lane + t]; w2[t] = cw[1024 + 8 * lane + t]; }
    for (int blk = blk0 + first; blk < blk1; blk += step) { const int row0 = 4 * blk;
        u32x4 bgw[4], vcw[6];
#pragma unroll
        for (int q = 0; q < 4; ++q) bgw[q] = *(const u32x4*)(BG + (size_t)(row0 + q) * 512 + 8 * lane);
#pragma unroll
        for (int q = 0; q < 6; ++q) { const int r = row0 - 2 + q; vcw[q] = r >= 0 ? *(const u32x4*)(VC + (size_t)r * 512 + 8 * lane) : (u32x4){0u, 0u, 0u, 0u}; }
#pragma unroll
        for (int q = 0; q < 4; ++q) { const int row = row0 + q, s = row & (SEQ - 1);
            float v0[8], v1[8], v2[8], bg[8];
            unpack8(vcw[q + 2], v0); unpack8(bgw[q], bg); unpack8(vcw[q + 1], v1); unpack8(vcw[q], v2);
            if (s < 1) {
#pragma unroll
                for (int t = 0; t < 8; ++t) v1[t] = 0.f; }
            if (s < 2) {
#pragma unroll
                for (int t = 0; t < 8; ++t) v2[t] = 0.f; }
            f32x4 r0, r1;
#pragma unroll
            for (int t = 0; t < 4; ++t) { r0[t] = bg[t] * (w0[t] * v2[t] + w1[t] * v1[t] + w2[t] * v0[t]); r1[t] = bg[4 + t] * (w0[4 + t] * v2[4 + t] + w1[4 + t] * v1[4 + t] + w2[4 + t] * v0[4 + t]); }
            *(u32x4*)(BZ + (size_t)row * 1024 + 8 * lane) = pack8(r0, r1); }
    }
}

__device__ __forceinline__ void phase5_ref(const KA& a, int gw, int NGW, int lane) {
    unsigned char* ws = a.ws; const bf16_t* Q = (const bf16_t*)(ws + WS_Q); const bf16_t* K = (const bf16_t*)(ws + WS_K); const bf16_t* V = (const bf16_t*)(ws + WS_V); bf16_t* O = (bf16_t*)(ws + WS_OB);
    int vz; asm volatile("v_mov_b32 %0, 0" : "=v"(vz));
    for (int uu = gw; uu < 4 * NH * 64; uu += NGW) {
        const int b = uu >> 9, h = (uu >> 6) & 7, cq = 63 - (uu & 63);
        const size_t row = (size_t)b * SEQ + cq * 64 + lane;
        float q[96];
#pragma unroll
        for (int c = 0; c < 12; ++c) unpack8(*(const u32x4*)(Q + row * 768 + h * 96 + 8 * c), q + 8 * c);
        float m = -1e30f, l = 0.f, o[64];
#pragma unroll
        for (int d = 0; d < 64; ++d) o[d] = 0.f;
        const int nk = (cq + 1) * 64;
        for (int key = 0; key < nk; ++key) {
            const size_t kr = (size_t)b * SEQ + key + vz;
            float s = 0.f;
#pragma unroll
            for (int c = 0; c < 12; ++c) { float kf[8]; unpack8(*(const u32x4*)(K + kr * 1024 + h * 128 + 8 * c), kf);
#pragma unroll
                for (int t = 0; t < 8; ++t) s = fmaf(q[8 * c + t], kf[t], s); }
            s *= ATT_SCALE;
            const float mn = fmaxf(m, s), al = __expf(m - mn), p = __expf(s - mn);
            l = l * al + p; m = mn;
#pragma unroll
            for (int c = 0; c < 8; ++c) { float vf[8]; unpack8(*(const u32x4*)(V + kr * 512 + h * 64 + 8 * c), vf);
#pragma unroll
                for (int t = 0; t < 8; ++t) o[8 * c + t] = fmaf(o[8 * c + t], al, p * vf[t]); }
        }
        const float rl = 1.0f / l;
#pragma unroll
        for (int c = 0; c < 8; ++c) { f32x4 r0, r1;
#pragma unroll
            for (int t = 0; t < 4; ++t) { r0[t] = o[8 * c + t] * rl; r1[t] = o[8 * c + 4 + t] * rl; }
            *(u32x4*)(O + row * 1024 + h * 64 + 8 * c) = pack8(r0, r1); }
    }
}


namespace at {
constexpr int NW = 8, QBLK = 32, KVBLK = 64, LDQ = 768, LDK = 1024, LDV = 512, LDO = 1024;
constexpr int SHM_V = 8192, SHM_K = 16384;
constexpr int L_V = 0, L_K = 2 * SHM_V, L_WS = L_K + 2 * SHM_K, L_OST = L_WS + NW * 256, L_END = L_OST + NW * 4096;
static_assert(L_END + 2 * 32 * 1040 <= LDS_MISC, "attention LDS + conversion slots");
constexpr float THR = 8.f;
typedef short s16x4 __attribute__((ext_vector_type(4)));
#define KSWZ(row, colB) ((row) * 256 + ((colB) ^ (((row) & 7) << 4)))
#define SBAR() __builtin_amdgcn_sched_barrier(0)
__device__ __forceinline__ int crow(int r, int hi) { return (r & 3) + 8 * (r >> 2) + 4 * hi; }
constexpr float THRL = 11.5f;
__device__ __forceinline__ void partialSM(f32x16& p0, f32x16& p1, float& mhat, float& negm, float& alpha, bool first) {
    float pmax = p0[0];
#pragma unroll
    for (int r = 1; r < 16; ++r) pmax = fmaxf(pmax, p0[r]);
#pragma unroll
    for (int r = 0; r < 16; ++r) pmax = fmaxf(pmax, p1[r]);
    { auto rr = __builtin_amdgcn_permlane32_swap(__float_as_uint(pmax), __float_as_uint(pmax), false, false);
      pmax = fmaxf(__uint_as_float(rr[0]), __uint_as_float(rr[1])); }
    alpha = 1.f;
    if (first || __any(pmax > THRL)) {
        const float dl = first ? pmax : fmaxf(pmax, 0.f);
        mhat += dl;
#pragma unroll
        for (int r = 0; r < 16; ++r) { p0[r] -= dl; p1[r] -= dl; }
        negm = -mhat;
        if (!first) alpha = __builtin_amdgcn_exp2f(-dl);
    }
#pragma unroll
    for (int r = 0; r < 16; ++r) p0[r] = __builtin_amdgcn_exp2f(p0[r]);
}
__device__ __forceinline__ void finishSM(f32x16& p0, f32x16& p1, float alpha, float& l_reg, bf16x8& pa0, bf16x8& pa1, bf16x8& pa2, bf16x8& pa3) {
#pragma unroll
    for (int r = 0; r < 16; ++r) p1[r] = __builtin_amdgcn_exp2f(p1[r]);
    float ps = 0;
#pragma unroll
    for (int r = 0; r < 16; ++r) ps += p0[r];
#pragma unroll
    for (int r = 0; r < 16; ++r) ps += p1[r];
    { auto rr = __builtin_amdgcn_permlane32_swap(__float_as_uint(ps), __float_as_uint(ps), false, false);
      ps = __uint_as_float(rr[0]) + __uint_as_float(rr[1]); }
    l_reg = l_reg * alpha + ps;
#define PK4(P, BASE, OUT) do { unsigned a0 = cvt_pk_bf16(P[BASE + 0], P[BASE + 1]), a1 = cvt_pk_bf16(P[BASE + 2], P[BASE + 3]);   \
    unsigned b0 = cvt_pk_bf16(P[BASE + 4], P[BASE + 5]), b1 = cvt_pk_bf16(P[BASE + 6], P[BASE + 7]);                              \
    auto r0 = __builtin_amdgcn_permlane32_swap(a0, b0, false, false); auto r1 = __builtin_amdgcn_permlane32_swap(a1, b1, false, false); \
    u32x4 w = {r0[0], r1[0], r0[1], r1[1]}; OUT = __builtin_bit_cast(bf16x8, w); } while (0)
    PK4(p0, 0, pa0); PK4(p0, 8, pa1); PK4(p1, 0, pa2); PK4(p1, 8, pa3);
#undef PK4
}
__device__ __forceinline__ void qkt(f32x16& p0, f32x16& p1, const LAS unsigned char* Ks, const bf16x8* qr, float negm_s, int r32, int hi) {
    asm volatile("" : "+v"(negm_s));
    f32x16 negm;
#pragma unroll
    for (int r = 0; r < 16; ++r) negm[r] = negm_s;
    int qb0_ = (int)(unsigned)(uintptr_t)(Ks + KSWZ(r32, hi * 16)), qb1_ = (int)(unsigned)(uintptr_t)(Ks + KSWZ(32 + r32, hi * 16)); asm volatile("" : "+v"(qb0_), "+v"(qb1_));
#define QK_RD(dst, base_, d0_) asm volatile("ds_read_b128 %0, %1" : "=v"(dst) : "v"((base_) ^ ((d0_) * 32)) : "memory")
#define QK_WAIT(n, x, y) asm volatile("s_waitcnt lgkmcnt(" #n ")" : "+v"(x), "+v"(y) :: "memory")
    bf16x8 f0, f1, f2, f3, f4, f5, f6, f7, f8, f9, f10, f11;
    QK_RD(f0, qb0_, 0); QK_RD(f1, qb1_, 0); QK_RD(f2, qb0_, 1); QK_RD(f3, qb1_, 1);
    QK_WAIT(2, f0, f1); p0 = __builtin_amdgcn_mfma_f32_32x32x16_bf16(f0, qr[0], negm, 0, 0, 0); p1 = __builtin_amdgcn_mfma_f32_32x32x16_bf16(f1, qr[0], negm, 0, 0, 0);
    QK_RD(f4, qb0_, 2); QK_RD(f5, qb1_, 2);
    QK_WAIT(2, f2, f3); p0 = __builtin_amdgcn_mfma_f32_32x32x16_bf16(f2, qr[1], p0, 0, 0, 0); p1 = __builtin_amdgcn_mfma_f32_32x32x16_bf16(f3, qr[1], p1, 0, 0, 0);
    QK_RD(f6, qb0_, 3); QK_RD(f7, qb1_, 3);
    QK_WAIT(2, f4, f5); p0 = __builtin_amdgcn_mfma_f32_32x32x16_bf16(f4, qr[2], p0, 0, 0, 0); p1 = __builtin_amdgcn_mfma_f32_32x32x16_bf16(f5, qr[2], p1, 0, 0, 0);
    QK_RD(f8, qb0_, 4); QK_RD(f9, qb1_, 4);
    QK_WAIT(2, f6, f7); p0 = __builtin_amdgcn_mfma_f32_32x32x16_bf16(f6, qr[3], p0, 0, 0, 0); p1 = __builtin_amdgcn_mfma_f32_32x32x16_bf16(f7, qr[3], p1, 0, 0, 0);
    QK_RD(f10, qb0_, 5); QK_RD(f11, qb1_, 5);
    QK_WAIT(2, f8, f9); p0 = __builtin_amdgcn_mfma_f32_32x32x16_bf16(f8, qr[4], p0, 0, 0, 0); p1 = __builtin_amdgcn_mfma_f32_32x32x16_bf16(f9, qr[4], p1, 0, 0, 0);
    QK_WAIT(0, f10, f11); p0 = __builtin_amdgcn_mfma_f32_32x32x16_bf16(f10, qr[5], p0, 0, 0, 0); p1 = __builtin_amdgcn_mfma_f32_32x32x16_bf16(f11, qr[5], p1, 0, 0, 0);
#undef QK_RD
#undef QK_WAIT
}
__device__ __forceinline__ int v_st(int k, int c) { const int kk = (k & ~0xC) | ((k & 4) << 1) | ((k & 8) >> 1); return ((kk >> 3) * 2 + (c >> 5)) * 512 + ((kk & 7) * 32 + (c & 31)) * 2; }
__device__ __forceinline__ int v_rd_base(int lane) { return ((lane & 3) << 3) | (((lane >> 2) & 3) << 6) | (((lane >> 4) & 1) << 5) | (((lane >> 5) & 1) << 8); }
constexpr int v_rd_off(int d0, int ks, int half) { return d0 * 512 + ks * 2048 + half * 1024; }
template <int OFF> __device__ __forceinline__ s16x4 tr_read(int vb) { s16x4 r; asm volatile("ds_read_b64_tr_b16 %0, %1 offset:%2" : "=&v"(r) : "v"(vb), "i"(OFF) : "memory"); return r; }
template <int D0> __device__ __forceinline__ void pv_one(f32x16& od, int vb, bf16x8 pa0, bf16x8 pa1, bf16x8 pa2, bf16x8 pa3) {
    const s16x4 l0 = tr_read<v_rd_off(D0, 0, 0)>(vb), h0 = tr_read<v_rd_off(D0, 0, 1)>(vb), l1 = tr_read<v_rd_off(D0, 1, 0)>(vb), h1 = tr_read<v_rd_off(D0, 1, 1)>(vb);
    const s16x4 l2 = tr_read<v_rd_off(D0, 2, 0)>(vb), h2 = tr_read<v_rd_off(D0, 2, 1)>(vb), l3 = tr_read<v_rd_off(D0, 3, 0)>(vb), h3 = tr_read<v_rd_off(D0, 3, 1)>(vb);
    asm volatile("s_waitcnt lgkmcnt(0)" ::: "memory"); SBAR();
#define PK(L, H) (bf16x8){L[0], L[1], L[2], L[3], H[0], H[1], H[2], H[3]}
    od = __builtin_amdgcn_mfma_f32_32x32x16_bf16(pa0, PK(l0, h0), od, 0, 0, 0);
    od = __builtin_amdgcn_mfma_f32_32x32x16_bf16(pa1, PK(l1, h1), od, 0, 0, 0);
    od = __builtin_amdgcn_mfma_f32_32x32x16_bf16(pa2, PK(l2, h2), od, 0, 0, 0);
    od = __builtin_amdgcn_mfma_f32_32x32x16_bf16(pa3, PK(l3, h3), od, 0, 0, 0);
#undef PK
}
__device__ __forceinline__ void pv_d0(f32x16* o, int vb, bf16x8 pa0, bf16x8 pa1, bf16x8 pa2, bf16x8 pa3) { pv_one<0>(o[0], vb, pa0, pa1, pa2, pa3); pv_one<1>(o[1], vb, pa0, pa1, pa2, pa3); }

__device__ __forceinline__ void attn_unit(int b, int h, int qb, const bf16_t* __restrict__ Q, const bf16_t* __restrict__ K, const bf16_t* __restrict__ V, bf16_t* __restrict__ O, LAS unsigned char* lds, const KA& a, ConvCtx& cx) {
    int tid_ = threadIdx.x; asm volatile("" : "+v"(tid_));
    const int tid = tid_, wid = __builtin_amdgcn_readfirstlane(tid >> 6), lane = tid & 63, r32 = lane & 31, hi = lane >> 5;
    LAS unsigned char* V_lds = lds + L_V; LAS unsigned char* K_lds = lds + L_K;
    LAS float* wsf = (LAS float*)(lds + L_WS) + wid * 64; LAS float* li_l = wsf; LAS float* al_l = wsf + 32; LAS unsigned char* Cs = lds + L_END;
    const size_t rowbase = (size_t)b * SEQ; const int q0 = qb * 256;
    const bf16_t* Kh = K + rowbase * LDK + h * 128; const bf16_t* Vh = V + rowbase * LDV + h * 64;
    float mhat = 0.f, l_reg = 0; f32x16 o[2] = {}; bf16x8 qr[6]; float negm = 0.f;
    const bf16_t* Qw = Q + (rowbase + q0 + wid * QBLK + r32) * LDQ + h * 96 + hi * 8;
#pragma unroll
    for (int d0 = 0; d0 < 6; ++d0) qr[d0] = *(const bf16x8*)(Qw + d0 * 16);
    const int cw = 4 * qb + (wid >> 1);
    const bool late = wid >= 4;
    const int sr = tid >> 4, sc = (tid & 15) * 8, vk = tid >> 3, vc = (tid & 7) * 8, vst = v_st(vk, vc); const bool kact = sc < 96; const int scl = kact ? sc : 0;
    const int vb0 = (int)(unsigned)(uintptr_t)V_lds + v_rd_base(lane);
    struct { bf16x8 vs, ks0, ks1; } sr_[2];
#define GLD128(dst, ptr) asm volatile("global_load_dwordx4 %0, %1, off" : "=v"(dst) : "v"(ptr) : "memory")
#define SLOAD(i, k0) do { GLD128(sr_[i].vs, Vh + (size_t)((k0) + vk) * LDV + vc); \
    GLD128(sr_[i].ks0, Kh + (size_t)((k0) + sr) * LDK + scl); GLD128(sr_[i].ks1, Kh + (size_t)((k0) + 32 + sr) * LDK + scl); } while (0)
#define SREADY(i, n) asm volatile("s_waitcnt vmcnt(" #n ")" : "+v"(sr_[i].vs), "+v"(sr_[i].ks0), "+v"(sr_[i].ks1) :: "memory")
#define LDS_ST128(addr, v) asm volatile("ds_write_b128 %0, %1" :: "v"(addr), "v"(v) : "memory")
#define SWRITE(bb, i) do { LDS_ST128((int)(unsigned)(uintptr_t)(V_lds + (bb) * SHM_V + vst), sr_[i].vs); const int kc = sc * 2; \
    if (kact) { LDS_ST128((int)(unsigned)(uintptr_t)(K_lds + (bb) * SHM_K + KSWZ(sr, kc)), sr_[i].ks0); LDS_ST128((int)(unsigned)(uintptr_t)(K_lds + (bb) * SHM_K + KSWZ(32 + sr, kc)), sr_[i].ks1); } } while (0)
#define SWAIT() asm volatile("s_waitcnt vmcnt(0)" ::: "memory")
#define WGBAR() do { asm volatile("s_waitcnt lgkmcnt(0)" ::: "memory"); __builtin_amdgcn_s_barrier(); asm volatile("" ::: "memory"); } while (0)
#define RESC(a) do { if (__any((a) < 1.f)) { if (hi == 0) asm volatile("ds_write_b32 %0, %1" :: "v"((int)(unsigned)(uintptr_t)(al_l + r32)), "v"(a) : "memory"); asm volatile("s_waitcnt lgkmcnt(0)" ::: "memory"); \
    _Pragma("unroll") for (int d = 0; d < 2; ++d) _Pragma("unroll") for (int r = 0; r < 16; ++r) o[d][r] *= al_l[crow(r, hi)]; } } while (0)
    f32x16 pA0, pA1, pB0, pB1; float alA = 1.f, alB = 1.f; bf16x8 pa0, pa1, pa2, pa3; const int NT = 4 * qb + 4;
    SLOAD(0, 0); SREADY(0, 0); SWRITE(0, 0); __syncthreads();
    SLOAD(1, KVBLK); SLOAD(0, 2 * KVBLK);
    qkt(pA0, pA1, K_lds, qr, negm, r32, hi); partialSM(pA0, pA1, mhat, negm, alA, true);
    SREADY(1, 3); SWRITE(1, 1); __syncthreads();
    for (int j = 1; j + 1 < NT; j += 2) {
        const bool v0 = j - 1 <= cw, v1 = j <= cw, v2 = j + 1 <= cw;
        const int t2 = j + 2 < NT ? j + 2 : NT - 1, t3 = j + 3 < NT ? j + 3 : NT - 1;
#define SYNC_EVEN(do_resc) do { WGBAR(); SREADY(0, 7); SWRITE(0, 0);        \
        if (do_resc) RESC(alB); asm volatile("s_waitcnt vmcnt(10)" ::: "memory");        \
        WGBAR(); } while (0)
#define SYNC_ODD(do_resc) do { WGBAR(); SREADY(1, 7); SWRITE(1, 1); CONV_TREAD(1);     \
        if (do_resc) RESC(alA); WGBAR(); } while (0)
        SBAR(); if (v1) qkt(pB0, pB1, K_lds + SHM_K, qr, negm, r32, hi);
        if (v0) finishSM(pA0, pA1, alA, l_reg, pa0, pa1, pa2, pa3); SBAR();
        SLOAD(1, t2 * KVBLK); CONV_DMA(); SBAR();
        if (v0) pv_d0(o, vb0, pa0, pa1, pa2, pa3); SBAR();
        if (late) SYNC_EVEN(false);
        alB = 1.f; if (v1) partialSM(pB0, pB1, mhat, negm, alB, false);
        if (late) RESC(alB); else SYNC_EVEN(true);
        SBAR(); if (v2) qkt(pA0, pA1, K_lds, qr, negm, r32, hi);
        if (v1) finishSM(pB0, pB1, alB, l_reg, pa0, pa1, pa2, pa3); SBAR();
        SLOAD(0, t3 * KVBLK); SBAR();
        if (v1) pv_d0(o, vb0 + SHM_V, pa0, pa1, pa2, pa3); SBAR();
        if (late) SYNC_ODD(false);
        alA = 1.f; if (v2) partialSM(pA0, pA1, mhat, negm, alA, false);
        if (late) RESC(alA); else SYNC_ODD(true);
    }
#undef SYNC_EVEN
#undef SYNC_ODD
    { const bool v0 = NT - 2 <= cw, v1 = NT - 1 <= cw;
    SBAR(); if (v1) qkt(pB0, pB1, K_lds + SHM_K, qr, negm, r32, hi);
    if (v0) finishSM(pA0, pA1, alA, l_reg, pa0, pa1, pa2, pa3); SBAR();
    if (v0) pv_d0(o, vb0, pa0, pa1, pa2, pa3); alB = 1.f; if (v1) partialSM(pB0, pB1, mhat, negm, alB, false);
    __syncthreads(); RESC(alB);
    if (v1) { finishSM(pB0, pB1, alB, l_reg, pa0, pa1, pa2, pa3); SBAR();
        pv_d0(o, vb0 + SHM_V, pa0, pa1, pa2, pa3); } }
    SREADY(0, 0);
    if (hi == 0) li_l[r32] = l_reg; asm volatile("s_waitcnt lgkmcnt(0)" ::: "memory");
    float rli[16];
#pragma unroll
    for (int r = 0; r < 16; ++r) rli[r] = __builtin_amdgcn_rcpf(li_l[crow(r, hi)]);
    LAS bf16_t* stg = (LAS bf16_t*)(lds + L_OST) + wid * 2048;
#pragma unroll
    for (int r = 0; r < 16; ++r) { const int orow = crow(r, hi);
#pragma unroll
        for (int d0 = 0; d0 < 2; ++d0) stg[orow * 64 + d0 * 32 + r32] = (bf16_t)(cvt_pk_bf16(o[d0][r] * rli[r], 0.f) & 0xffffu); }
    asm volatile("s_waitcnt lgkmcnt(0)" ::: "memory");
    bf16_t* Ow = O + (rowbase + q0 + wid * QBLK) * LDO + h * 64;
#pragma unroll
    for (int i = 0; i < 4; ++i) { const int row = i * 8 + (lane >> 3), ch = lane & 7; const u32x4 v = *(const LAS u32x4*)(stg + row * 64 + ch * 8); *(u32x4*)(Ow + (size_t)row * LDO + ch * 8) = v; }
    asm volatile("s_waitcnt lgkmcnt(0)" ::: "memory"); __syncthreads();
#undef SLOAD
#undef GLD128
#undef SREADY
#undef SWRITE
#undef LDS_ST128
#undef SWAIT
#undef WGBAR
#undef RESC
}
#undef KSWZ
#undef SBAR
}
__device__ __forceinline__ void phase5_fast(const KA& a, LAS unsigned char* lds) {
    unsigned char* ws = a.ws; const bf16_t* Q = (const bf16_t*)(ws + WS_Q); const bf16_t* K = (const bf16_t*)(ws + WS_K); const bf16_t* V = (const bf16_t*)(ws + WS_V); bf16_t* O = (bf16_t*)(ws + WS_OB);
    const int G = gridDim.x, bx = blockIdx.x; const int vcu = (G % 8 == 0) ? (bx % 8) * (G / 8) + bx / 8 : bx;
    ConvCtx cx; cx.c = 0; cx.r = 0; { const int spw = (CONV_SLICES + G - 1) / G; cx.s0 = bx * spw; const int left = CONV_SLICES - cx.s0; cx.ns = MOE_FP8 ? (left < 0 ? 0 : (left < spw ? left : spw)) : 0; }
    int tid = threadIdx.x; asm volatile("" : "+v"(tid)); const int wid = __builtin_amdgcn_readfirstlane(tid >> 6), lane = tid & 63; LAS unsigned char* Cs = lds + at::L_END;
#define CONV_DRAIN() do { asm volatile("s_waitcnt vmcnt(0)" ::: "memory"); __syncthreads(); CONV_TREAD(0); CONV_TREAD(0); __syncthreads(); } while (0)
    for (int it = vcu; it < 4 * NH * 8; it += G) { const int bh = it >> 3, s8 = it & 7;
        const bool longfirst = (s8 & 2) != 0;
        const int qfirst = longfirst ? 15 - s8 : s8, qsecond = longfirst ? s8 : 15 - s8;
        at::attn_unit(bh >> 3, bh & 7, qfirst, Q, K, V, O, lds, a, cx);
        if (MOE_FP8 && it == vcu) { CONV_DRAIN(); expert_weight_share(a, lds); }
        at::attn_unit(bh >> 3, bh & 7, qsecond, Q, K, V, O, lds, a, cx); }
    if (MOE_FP8 && vcu >= 4 * NH * 8) expert_weight_share(a, lds);
    CONV_DRAIN();
#pragma unroll 1
    while (cx.c < cx.ns) { CONV_DMA(); CONV_DRAIN(); }
#undef CONV_DRAIN
}

constexpr int HB_PITCH = 1028;
constexpr int R_AF = 32 * HB_PITCH * 4, R_SHF = R_AF + 4096, R_HIST = R_SHF + 4096;
static_assert(R_HIST + 256 <= LDS_MOE, "router LDS");
__device__ __forceinline__ void phase8(const KA& a, LAS unsigned char* lds, int tid, int wave, int lane) {
    unsigned char* ws = a.ws; const bf16_t* X1 = (const bf16_t*)(ws + WS_X1); const float* ada = (const float*)(ws + WS_ADA); const float* gffn = (const float*)a.in(I_GFFN);
    const float* rw = (const float*)a.in(I_RW); const float* rb = (const float*)a.in(I_RB);
    bf16_t* H2 = (bf16_t*)(ws + WS_H); int* RFLAT = (int*)(ws + WS_RFLAT); float* GW = (float*)(ws + WS_GW); unsigned* cnt = (unsigned*)(ws + WS_CTL) + CW_CNT;
    LAS float* HB = (LAS float*)lds; LAS float* AF = (LAS float*)(lds + R_AF); LAS float* SHF = (LAS float*)(lds + R_SHF);
    LAS float* PART = (LAS float*)lds;
    LAS float* LOG = (LAS float*)(lds + 32768);
    LAS int* HIST = (LAS int*)(lds + R_HIST);
    LAS int* BASE = HIST + 32;
    float rwv[64];
    { const int i = lane & 31, half = lane >> 5, kb = wave * 128;
#pragma unroll
        for (int jj = 0; jj < 16; ++jj)
#pragma unroll
            for (int t = 0; t < 4; ++t) rwv[jj * 4 + t] = rw[(size_t)(kb + 8 * jj + 4 * half + t) * 32 + i]; }
    for (int blk = blockIdx.x; blk < T / 64; blk += gridDim.x) {
        const int b = (blk * 64) >> 12;
        __syncthreads();
        for (int n = tid; n < 1024; n += NTHREADS) { AF[n] = gffn[n] * (1.0f + ada[b * 6144 + 4096 + n]); SHF[n] = ada[b * 6144 + 3072 + n]; }
        if (tid < 32) HIST[tid] = 0;
        int se[2][2], sl[2][2]; float sw[2][2];
#pragma unroll
        for (int pass = 0; pass < 2; ++pass) {
            const int tok0 = blk * 64 + 32 * pass;
            __syncthreads();
            { u32x2 xw[4][4]; f32x4 v[4][4]; float ss[4];
#pragma unroll
              for (int r = 0; r < 4; ++r)
#pragma unroll
                  for (int j = 0; j < 4; ++j) xw[r][j] = *(const u32x2*)(X1 + (size_t)(tok0 + wave * 4 + r) * 1024 + 4 * lane + 256 * j);
#pragma unroll
              for (int r = 0; r < 4; ++r) { float s_ = 0.f;
#pragma unroll
                  for (int j = 0; j < 4; ++j) { v[r][j] = (f32x4){bf_lo(xw[r][j].x), bf_hi(xw[r][j].x), bf_lo(xw[r][j].y), bf_hi(xw[r][j].y)}; s_ += (v[r][j][0] * v[r][j][0] + v[r][j][1] * v[r][j][1]) + (v[r][j][2] * v[r][j][2] + v[r][j][3] * v[r][j][3]); }
                  ss[r] = s_; }
#pragma unroll
              for (int o = 1; o < 64; o <<= 1) {
#pragma unroll
                  for (int r = 0; r < 4; ++r) ss[r] += __shfl_xor(ss[r], o); }
#pragma unroll
              for (int r = 0; r < 4; ++r) { const size_t row = (size_t)tok0 + wave * 4 + r; const float rstd = 1.0f / sqrtf(ss[r] * (1.0f / 1024.0f) + RMS_EPS);
#pragma unroll
                  for (int j = 0; j < 4; ++j) { const int c0 = 4 * lane + 256 * j; const f32x4 h = v[r][j] * rstd * *(const LAS f32x4*)(AF + c0) + *(const LAS f32x4*)(SHF + c0);
                      if (MOE_FP8) *(unsigned*)((unsigned char*)H2 + row * 1024 + c0) = pack4_fp8(h); else *(u32x2*)(H2 + row * 1024 + c0) = pack4(h);
                      *(LAS f32x4*)(HB + (wave * 4 + r) * HB_PITCH + c0) = h; } } }
            __syncthreads();
            f32x16 acc = {};
            { const int i = lane & 31, half = lane >> 5, kb = wave * 128;
#pragma unroll
                for (int jj = 0; jj < 16; ++jj) { const f32x4 a4 = *(const LAS f32x4*)(HB + i * HB_PITCH + kb + 8 * jj + 4 * half);
#pragma unroll
                    for (int t = 0; t < 4; ++t) acc = __builtin_amdgcn_mfma_f32_32x32x2f32(a4[t], rwv[jj * 4 + t], acc, 0, 0, 0); } }
            __syncthreads();
            { const int e = lane & 31, half = lane >> 5;
#pragma unroll
                for (int r = 0; r < 16; ++r) { const int tk = (r & 3) + 8 * (r >> 2) + 4 * half; PART[(wave * 32 + tk) * 32 + e] = acc[r]; } }
            __syncthreads();
            for (int idx = tid; idx < 1024; idx += NTHREADS) { const int tk = idx >> 5, e = idx & 31; float s_ = rb[e];
#pragma unroll
                for (int w = 0; w < 8; ++w) s_ += PART[(w * 32 + tk) * 32 + e];
                LOG[tk * 33 + e] = s_; }
            __syncthreads();
#pragma unroll
            for (int it2 = 0; it2 < 2; ++it2) { const int e = lane & 31, half = lane >> 5, tk = wave * 4 + 2 * it2 + half;
                float v = LOG[tk * 33 + e]; float tv[4]; int te[4];
#pragma unroll
                for (int k = 0; k < 4; ++k) { float m = v;
#pragma unroll
                    for (int o = 1; o < 32; o <<= 1) m = fmaxf(m, __shfl_xor(m, o));
                    const unsigned long long bal = __ballot(v == m); const unsigned hm = (unsigned)(bal >> (32 * half));
                    const int idx = __builtin_ctz(hm); tv[k] = m; te[k] = idx; if (e == idx) v = -INFINITY; }
                float ex[4], sum = 0.f;
#pragma unroll
                for (int k = 0; k < 4; ++k) { ex[k] = expf(tv[k] - tv[0]); sum += ex[k]; }
                const int k = e & 3; const int myE = k == 0 ? te[0] : k == 1 ? te[1] : k == 2 ? te[2] : te[3]; const float myX = k == 0 ? ex[0] : k == 1 ? ex[1] : k == 2 ? ex[2] : ex[3];
                se[pass][it2] = myE; sw[pass][it2] = myX / sum; sl[pass][it2] = 0;
                if (e < 4) sl[pass][it2] = __hip_atomic_fetch_add(&HIST[myE], 1, __ATOMIC_RELAXED, __HIP_MEMORY_SCOPE_WORKGROUP); }
        }
        __syncthreads();
        if (tid < 32) { const int h = HIST[tid]; BASE[tid] = h ? (int)__hip_atomic_fetch_add(cnt + 64 * tid, (unsigned)h, __ATOMIC_RELAXED, __HIP_MEMORY_SCOPE_AGENT) : 0; }
        __syncthreads();
        if ((lane & 31) < 4) {
#pragma unroll
            for (int pass = 0; pass < 2; ++pass)
#pragma unroll
                for (int it2 = 0; it2 < 2; ++it2) { const int tk = blk * 64 + 32 * pass + wave * 4 + 2 * it2 + (lane >> 5); const int f = 4 * tk + (lane & 3);
                    const int pos = BASE[se[pass][it2]] + sl[pass][it2]; RFLAT[(size_t)se[pass][it2] * ECAP + pos] = f; GW[f] = sw[pass][it2]; } }
    }
}

__device__ __forceinline__ void moe_setup(const KA& a, LAS unsigned char* lds, int tid, ge::MoeSched& S, int nN, bool gather) {
    unsigned char* ws = a.ws; unsigned* cnt = (unsigned*)(ws + WS_CTL) + CW_CNT; const int* RFLAT = (const int*)(ws + WS_RFLAT);
    LAS int* tb = (LAS int*)(lds + LDS_MOE); LAS int* CNT = tb + 40; LAS unsigned* tab = (LAS unsigned*)(lds + LDS_TAB);
    __syncthreads();
    if (tid < NE) CNT[tid] = (int)__hip_atomic_load(cnt + 64 * tid, __ATOMIC_RELAXED, __HIP_MEMORY_SCOPE_AGENT);
    __syncthreads();
    if (tid == 0) { int s = 0; for (int e = 0; e < NE; ++e) { tb[e] = s; s += (CNT[e] + 255) >> 8; } tb[NE] = s; }
    __syncthreads();
    S.tb = tb; S.tab = tab; S.nN = nN; S.ntiles = __builtin_amdgcn_readfirstlane(tb[NE]); S.G = gridDim.x; S.c = blockIdx.x; S.gather = gather;
    if (gather) {
        Unit u;
        for (int ui = 0; ui < TAB_UNITS && S.next(ui, u); ++ui)
            if (tid < 256) { const int rr = u.aux * 256 + tid; const int f = rr < CNT[u.e] ? RFLAT[(size_t)u.e * ECAP + rr] : 0; tab[ui * 256 + tid] = (unsigned)(f >> 2) * (unsigned)(1024 * ME); }
        __syncthreads();
    }
}

__device__ __forceinline__ void phase11(const KA& a, LAS unsigned char* lds, int tid, int wave, int lane) {
    unsigned char* ws = a.ws; const bf16_t* X1 = (const bf16_t*)(ws + WS_X1); float* OUT = a.out; const float* ada = (const float*)(ws + WS_ADA); const float* gfin = (const float*)a.in(I_GFIN);
    const unsigned char* Y = (const unsigned char*)(ws + WS_Y); const float* GW = (const float*)(ws + WS_GW);
    LAS float* GF = (LAS float*)lds; LAS float* GN = GF + 1024;
    for (int rb = blockIdx.x; rb < T / 64; rb += gridDim.x) {
        const int b = rb / 64;
        __syncthreads();
        for (int n = tid; n < 1024; n += NTHREADS) { GF[n] = ada[b * 6144 + 5120 + n]; GN[n] = gfin[n]; }
        __syncthreads();
        for (int r = wave; r < 64; r += NWAVES) { const size_t row = (size_t)rb * 64 + r;
            const f32x4 gw4 = *(const f32x4*)(GW + row * 4);
            f32x4 x2[4]; float s = 0.f;
#pragma unroll
            for (int j = 0; j < 4; ++j) { const int c0 = 4 * lane + 256 * j; f32x4 y = {0.f, 0.f, 0.f, 0.f};
#pragma unroll
                for (int k = 0; k < 4; ++k) { f32x4 yk;
                    if (Y_FP8) { const int w = *(const int*)(Y + (row * 4 + k) * 1024 + c0); yk = (f32x4){__builtin_amdgcn_cvt_f32_fp8(w, 0), __builtin_amdgcn_cvt_f32_fp8(w, 1), __builtin_amdgcn_cvt_f32_fp8(w, 2), __builtin_amdgcn_cvt_f32_fp8(w, 3)} * 0.0625f; }
                    else { const u32x2 w = *(const u32x2*)(Y + ((row * 4 + k) * 1024 + c0) * 2); yk = (f32x4){bf_lo(w.x), bf_hi(w.x), bf_lo(w.y), bf_hi(w.y)}; }
                    y += yk * gw4[k]; }
                const u32x2 xw = *(const u32x2*)(X1 + row * 1024 + c0); const f32x4 x1v = {bf_lo(xw.x), bf_hi(xw.x), bf_lo(xw.y), bf_hi(xw.y)};
                x2[j] = x1v + *(const LAS f32x4*)(GF + c0) * y;
                s += (x2[j][0] * x2[j][0] + x2[j][1] * x2[j][1]) + (x2[j][2] * x2[j][2] + x2[j][3] * x2[j][3]); }
            const float rstd = 1.0f / sqrtf(wave_sum(s) * (1.0f / 1024.0f) + RMS_EPS);
#pragma unroll
            for (int j = 0; j < 4; ++j) { const int c0 = 4 * lane + 256 * j; *(f32x4*)(OUT + row * 1024 + c0) = x2[j] * rstd * *(const LAS f32x4*)(GN + c0); }
        }
    }
}

__global__ void __launch_bounds__(NTHREADS, 2) fwd_kernel(Args args) {
    extern __shared__ __attribute__((aligned(16))) unsigned char lds_raw[];
    LAS unsigned char* lds = (LAS unsigned char*)lds_raw;
    const int tid = threadIdx.x, lane = tid & 63, wave = __builtin_amdgcn_readfirstlane(tid >> 6);
    const int G = gridDim.x, gw = blockIdx.x * NWAVES + wave, NGW = G * NWAVES;
    unsigned char* ws = args.ws;
    KA ka; ka.kp = (kptr_t)__builtin_amdgcn_kernarg_segment_ptr(); ka.ws = args.ws; ka.out = args.out;
    volatile LAS unsigned* MISC = (volatile LAS unsigned*)(lds + LDS_MISC);
    if (tid < 32) MISC[tid] = 0u;
    __syncthreads();
    unsigned* ctl = (unsigned*)(ws + WS_CTL);
    XcdBarrier bar; bar.bar = ctl + CW_BAR; bar.x = 0; bar.st = nullptr;
    if (MK_N_LAUNCHES == 1) bar = xcd_barrier_post(ctl + CW_BAR, MISC + 8);
    const int lo = args.ph_lo, hi = args.ph_hi;
#ifndef PHASE_MASK
#define PHASE_MASK 0xFFF
#endif
#define IN(k) ((((PHASE_MASK) >> (k)) & 1) && lo <= (k) && (k) < hi)
#ifndef REP_PHASE
#define REP_PHASE -1
#endif
#define SEAM(k) do { if (IN(k) && IN((k) + 1)) xcd_barrier(bar); } while (0)
#define REPS(k) for (int rep_ = 0; rep_ < ((REP_PHASE) == (k) ? 2 : 1); ++rep_, ((REP_PHASE) == (k) && rep_ < 2 && MK_N_LAUNCHES == 1 ? xcd_barrier(bar) : (void)0))

    if (IN(0)) REPS(0) { phase0(ka, lds, gw, NGW, wave, lane); } SEAM(0);
    if (IN(1)) REPS(1) { phase1(ka, lds, tid, wave, lane); } SEAM(1);
    if (IN(2)) REPS(2) {
        ge::Gemm g{(const char*)(ws + WS_H), (const char*)(ws + WS_WIN), 2048, 2048, 2048};
        ge::DenseSched S; S.init(T, NIN, G, blockIdx.x, 2048, 2048);
        EpiInProj E{(bf16_t*)(ws + WS_LAT), (bf16_t*)(ws + WS_VC), (bf16_t*)(ws + WS_BG), (bf16_t*)(ws + WS_SG), (float*)(ws + WS_RSTDQ), (float*)(ws + WS_RSTDKV), (const float*)(ws + WS_CS), (const float*)(ws + WS_SN), (bf16_t*)(ws + WS_K), (LAS float*)(lds + LDS_TAB)};
        run_gemm<FAST_P2 != 0, false, false>(lds, g, S, E);
    } SEAM(2);
    if (IN(4)) REPS(4) {
        ge::Gemm g{(const char*)(ws + WS_LAT), (const char*)(ws + WS_WUP), 1024, 512, 512};
        ge::DenseSched S; S.init(T, 1792, G, blockIdx.x, 1024, 512, 3, 512);
        EpiUp E{(bf16_t*)(ws + WS_Q), (bf16_t*)(ws + WS_K), (bf16_t*)(ws + WS_V), (const float*)(ws + WS_RSTDQ), (const float*)(ws + WS_RSTDKV), (const float*)(ws + WS_CS), (const float*)(ws + WS_SN)};
        run_gemm<FAST_P4 != 0, false, false>(lds, g, S, E);
        if (G == 256) { const int c = blockIdx.x; const int b0 = c < 192 ? 10 * c : 1920 + 34 * (c - 192), b1 = b0 + (c < 192 ? 10 : 34); conv_rows(ka, b0, b1, wave, NWAVES, lane); }
        else conv_rows(ka, 0, T / 4, gw, NGW, lane);
    } SEAM(4);
    if (IN(5)) REPS(5) { if (FAST_ATTN) phase5_fast(ka, lds); else phase5_ref(ka, gw, NGW, lane); } SEAM(5);
    if (IN(6)) REPS(6) {
        ge::Gemm g{(const char*)(ws + WS_OB), (const char*)(ws + WS_WA), 2048, 2048, 2048};
        ge::DenseSched S; S.init(T, 1024, G, blockIdx.x, 2048, 2048);
        EpiMerged E{(const bf16_t*)(ws + WS_SG), (bf16_t*)(ws + WS_MRG)};
        run_gemm<FAST_P6 != 0, false, false>(lds, g, S, E);
    } SEAM(6);
    if (IN(7)) REPS(7) {
        ge::Gemm g{(const char*)(ws + WS_MRG), (const char*)(ws + WS_WO), 2048, 2048, 2048};
        ge::DenseSched S; S.init(T, 1024, G, blockIdx.x, 2048, 2048);
        EpiWo E{(const float*)ka.in(I_X), (const float*)(ws + WS_ADA), (bf16_t*)(ws + WS_X1)};
        run_gemm<FAST_P7 != 0, false, false>(lds, g, S, E);
    } SEAM(7);
    if (IN(8)) REPS(8) { phase8(ka, lds, tid, wave, lane); } SEAM(8);
    if (IN(9)) REPS(9) {
        ge::MoeSched S; S.lda = 1024 * ME; S.ldb = 1024 * ME; S.nper = 2048; moe_setup(ka, lds, tid, S, 8, true);
        ge::Gemm g{(const char*)(ws + WS_H), (const char*)(ws + WS_WGU), 1024 * ME, 1024 * ME, 1024 * ME};
        EpiGU E{(const float*)ka.in(I_BGU), (unsigned char*)(ws + WS_ACT)};
        run_gemm<FAST_P9 != 0, true, MOE_FP8 != 0>(lds, g, S, E);
    } SEAM(9);
    if (IN(10)) REPS(10) {
        ge::MoeSched S; S.lda = 1024 * ME; S.ldb = 1024 * ME; S.nper = 1024; moe_setup(ka, lds, tid, S, 4, false);
        ge::Gemm g{(const char*)(ws + WS_ACT), (const char*)(ws + WS_WD), 1024 * ME, 1024 * ME, 1024 * ME};
        EpiDown E{(const float*)ka.in(I_BD), (const int*)(ws + WS_RFLAT), (const LAS int*)(lds + LDS_MOE) + 40, (unsigned char*)(ws + WS_Y)};
        run_gemm<FAST_P10 != 0, false, MOE_FP8 != 0>(lds, g, S, E);
    } SEAM(10);
    if (IN(11)) REPS(11) { phase11(ka, lds, tid, wave, lane); }
#undef IN
#undef SEAM
}

extern "C" void kernel_launch(void* const* d_in, const int* in_sizes, int n_in, void* d_out, int out_size, void* d_ws, size_t ws_size, hipStream_t stream) {
    static int grid = 0;
    if (grid == 0) {
        if (n_in != 23 || in_sizes[0] != T * D || out_size != T * D || ws_size < WS_END) {
            fprintf(stderr, "kernel_launch: unexpected problem: n_in %d in0 %d out %d ws %zu (need >= %zu)\n", n_in, n_in > 0 ? in_sizes[0] : -1, out_size, ws_size, (size_t)WS_END); grid = -1; return; }
        int dev = 0, cus = 0, per_cu = 0;
        if (hipGetDevice(&dev) != hipSuccess || hipDeviceGetAttribute(&cus, hipDeviceAttributeMultiprocessorCount, dev) != hipSuccess) { grid = -1; return; }
        if (hipFuncSetAttribute((const void*)fwd_kernel, hipFuncAttributeMaxDynamicSharedMemorySize, LDS_BYTES) != hipSuccess) { fprintf(stderr, "kernel_launch: hipFuncSetAttribute failed\n"); grid = -1; return; }
        if (hipOccupancyMaxActiveBlocksPerMultiprocessor(&per_cu, (const void*)fwd_kernel, NTHREADS, LDS_BYTES) != hipSuccess || per_cu < 1) {
            fprintf(stderr, "kernel_launch: occupancy query says %d blocks per CU\n", per_cu); (void)hipGetLastError(); grid = -1; return; }
        grid = cus;
    }
    if (grid < 0) return;
    (void)hipMemsetAsync((char*)d_ws + WS_CTL, 0, CTL_ZERO_BYTES, stream);
    Args a{};
    for (int i = 0; i < 23; ++i) a.in[i] = d_in[i];
    a.out = (float*)d_out; a.ws = (unsigned char*)d_ws;
    if (MK_N_LAUNCHES == 1) {
        a.ph_lo = 0; a.ph_hi = NPHASE; a.li = 0;
        hipLaunchKernelGGL(fwd_kernel, dim3(grid), dim3(NTHREADS), LDS_BYTES, stream, a);
    } else {
        for (int p = 0; p < NPHASE; ++p) { a.ph_lo = p; a.ph_hi = p + 1; a.li = p; hipLaunchKernelGGL(fwd_kernel, dim3(grid), dim3(NTHREADS), LDS_BYTES, stream, a); }
    }
    const hipError_t le = hipPeekAtLastError();
    if (le != hipSuccess) fprintf(stderr, "kernel_launch: launch failed: %s\n", hipGetErrorName(le));
}
```

```cpp
#include <hip/hip_runtime.h>
#include <cstdio>
#include <cstdint>

#define LAS __attribute__((address_space(3)))
#define GAS __attribute__((address_space(1)))
typedef unsigned short bf16_t;
typedef short bf16x8 __attribute__((ext_vector_type(8)));
typedef float f32x4 __attribute__((ext_vector_type(4)));
typedef float f32x16 __attribute__((ext_vector_type(16)));
typedef unsigned u32x4 __attribute__((ext_vector_type(4)));
typedef unsigned u32x2 __attribute__((ext_vector_type(2)));
typedef int v8i __attribute__((ext_vector_type(8)));
typedef int v8i_a16 __attribute__((ext_vector_type(8), aligned(16)));

#ifndef MK_N_LAUNCHES
#define MK_N_LAUNCHES 1
#endif
#ifndef FAST_P2
#define FAST_P2 1
#endif
#ifndef FAST_P4
#define FAST_P4 1
#endif
#ifndef FAST_P6
#define FAST_P6 1
#endif
#ifndef FAST_P7
#define FAST_P7 1
#endif
#ifndef FAST_P9
#define FAST_P9 1
#endif
#ifndef FAST_P10
#define FAST_P10 1
#endif
#ifndef MOE_FP8
#define MOE_FP8 1
#endif
constexpr float W8S = MOE_FP8 ? 0.015625f : 1.0f;
constexpr int ME = MOE_FP8 ? 1 : 2;
#ifndef Y_FP8
#define Y_FP8 1
#endif
#ifndef FAST_ATTN
#define FAST_ATTN 1
#endif
constexpr int NPHASE = 12;
constexpr int NWAVES = 8, NTHREADS = 512;

constexpr int T = 16384, D = 1024, SEQ = 4096, NH = 8;
constexpr int INW = 4000, NIN = 4096;
constexpr int NE = 32, ECAP = 16384;
constexpr float RMS_EPS = 1e-6f;
constexpr float ATT_SCALE = 0.10206207261596575f;
#if FAST_ATTN
constexpr float QSCALE = ATT_SCALE * 1.4426950408889634f;
#else
constexpr float QSCALE = 1.0f;
#endif

constexpr size_t MiB = 1u << 20;
constexpr size_t WS_CTL = 0, CTL_ZERO_BYTES = 64 * 1024;
constexpr size_t WS_ADAP = 1 * MiB, WS_ADA = 3 * MiB, WS_RSTDQ = 4 * MiB, WS_RSTDKV = 4 * MiB + 512 * 1024, WS_CS = 5 * MiB, WS_SN = 6 * MiB, WS_GW = 7 * MiB, WS_RFLAT = 8 * MiB;
constexpr size_t WS_WIN = 10 * MiB, WS_WUP = 18 * MiB, WS_WA = 19 * MiB, WS_WC = 20 * MiB, WS_WO = 21 * MiB, WS_WGU = 24 * MiB, WS_WD = 152 * MiB;
constexpr size_t WS_H = 216 * MiB, WS_LAT = 248 * MiB, WS_VC = 264 * MiB, WS_BG = 280 * MiB, WS_SG = 296 * MiB, WS_BZ = 360 * MiB;
constexpr size_t WS_Q = 376 * MiB, WS_K = 400 * MiB, WS_V = 432 * MiB, WS_O = 448 * MiB, WS_TMP = 464 * MiB, WS_MRG = 496 * MiB;
constexpr size_t WS_OB = WS_TMP;
constexpr size_t WS_X1 = WS_O;
constexpr size_t WS_ACT = 528 * MiB, WS_Y = 672 * MiB, WS_END = 800 * MiB;
constexpr int CW_BAR = 4096, CW_CNT = 8192;

constexpr int RING_BYTES = 131072;
constexpr int LDS_TAB = 131072, TAB_UNITS = 12;
constexpr int LDS_MOE = LDS_TAB + TAB_UNITS * 1024;
constexpr int LDS_BYTES = 155648;
constexpr int LDS_MISC = LDS_BYTES - 256;
static_assert(LDS_MISC + 128 <= LDS_BYTES && LDS_MOE + 512 <= LDS_MISC, "LDS map");

__device__ __forceinline__ float bf_lo(unsigned w) { return __uint_as_float(w << 16); }
__device__ __forceinline__ float bf_hi(unsigned w) { return __uint_as_float(w & 0xffff0000u); }
__device__ __forceinline__ unsigned cvt_pk_bf16(float lo, float hi) { unsigned r; asm volatile("v_cvt_pk_bf16_f32 %0, %1, %2" : "=v"(r) : "v"(lo), "v"(hi)); return r; }
__device__ __forceinline__ u32x4 pack8(f32x4 a, f32x4 b) { u32x4 w; w.x = cvt_pk_bf16(a[0], a[1]); w.y = cvt_pk_bf16(a[2], a[3]); w.z = cvt_pk_bf16(b[0], b[1]); w.w = cvt_pk_bf16(b[2], b[3]); return w; }
__device__ __forceinline__ unsigned pack4_fp8(f32x4 a) { int w = __builtin_amdgcn_cvt_pk_fp8_f32(a[0], a[1], 0, false); return (unsigned)__builtin_amdgcn_cvt_pk_fp8_f32(a[2], a[3], w, true); }
__device__ __forceinline__ u32x2 pack8_fp8(f32x4 a, f32x4 b) { u32x2 w; w.x = pack4_fp8(a); w.y = pack4_fp8(b); return w; }
__device__ __forceinline__ u32x2 pack4(f32x4 a) { u32x2 w; w.x = cvt_pk_bf16(a[0], a[1]); w.y = cvt_pk_bf16(a[2], a[3]); return w; }
__device__ __forceinline__ void unpack8(u32x4 w, float* f) { f[0] = bf_lo(w.x); f[1] = bf_hi(w.x); f[2] = bf_lo(w.y); f[3] = bf_hi(w.y); f[4] = bf_lo(w.z); f[5] = bf_hi(w.z); f[6] = bf_lo(w.w); f[7] = bf_hi(w.w); }
__device__ __forceinline__ float wave_sum(float v) {
#pragma unroll
    for (int o = 1; o < 64; o <<= 1) v += __shfl_xor(v, o);
    return v;
}
__device__ __forceinline__ u32x2 pack8_u8(f32x4 a, f32x4 b) { unsigned w0 = 0, w1 = 0;
    w0 = __builtin_amdgcn_cvt_pk_u8_f32(fmaxf(a[0] * 255.0f, 1.0f), 0, w0); w0 = __builtin_amdgcn_cvt_pk_u8_f32(fmaxf(a[1] * 255.0f, 1.0f), 1, w0);
    w0 = __builtin_amdgcn_cvt_pk_u8_f32(fmaxf(a[2] * 255.0f, 1.0f), 2, w0); w0 = __builtin_amdgcn_cvt_pk_u8_f32(fmaxf(a[3] * 255.0f, 1.0f), 3, w0);
    w1 = __builtin_amdgcn_cvt_pk_u8_f32(fmaxf(b[0] * 255.0f, 1.0f), 0, w1); w1 = __builtin_amdgcn_cvt_pk_u8_f32(fmaxf(b[1] * 255.0f, 1.0f), 1, w1);
    w1 = __builtin_amdgcn_cvt_pk_u8_f32(fmaxf(b[2] * 255.0f, 1.0f), 2, w1); w1 = __builtin_amdgcn_cvt_pk_u8_f32(fmaxf(b[3] * 255.0f, 1.0f), 3, w1);
    return (u32x2){w0, w1}; }
__device__ __forceinline__ void unpack8_u8(u32x2 w, float* f) {
    f[0] = (float)(w.x & 0xffu); f[1] = (float)((w.x >> 8) & 0xffu); f[2] = (float)((w.x >> 16) & 0xffu); f[3] = (float)(w.x >> 24);
    f[4] = (float)(w.y & 0xffu); f[5] = (float)((w.y >> 8) & 0xffu); f[6] = (float)((w.y >> 16) & 0xffu); f[7] = (float)(w.y >> 24); }
__device__ __forceinline__ float fast_sigmoid(float x) { return __builtin_amdgcn_rcpf(1.0f + __builtin_amdgcn_exp2f(-1.4426950408889634f * x)); }
#define LDS_WAIT() asm volatile("s_waitcnt lgkmcnt(0)" ::: "memory")
#define VM_WAIT() asm volatile("s_waitcnt vmcnt(0)" ::: "memory")

#define XB_TMO      128
#define XB_XCNT(j)  (256  + 64 * (j))
#define XB_XSUB(j)  (1280 + 64 * (j))
#define XB_XGEN(j)  (2304 + 64 * (j))
#define XB_TOP      3328
#define XB_TOPGEN   3392
#define XCD_BAR_WORDS 3456
#define XB_SPIN_CAP (1u << 22)
__device__ __forceinline__ unsigned xb_ld(unsigned* p)              { return __hip_atomic_load(p, __ATOMIC_RELAXED, __HIP_MEMORY_SCOPE_AGENT); }
__device__ __forceinline__ unsigned xb_add(unsigned* p, unsigned v) { return __hip_atomic_fetch_add(p, v, __ATOMIC_RELAXED, __HIP_MEMORY_SCOPE_AGENT); }
__device__ __forceinline__ unsigned xb_xcc_id() { return (unsigned)__builtin_amdgcn_s_getreg((3 << 11) | 20) & 0xFu; }
#define XB_SPIN(cond, bar) do { unsigned _sp = 0; while (cond) { __builtin_amdgcn_s_sleep(1); \
    if ((++_sp & 255u) == 0u) { if (xb_ld(&(bar)[XB_TMO])) break; if (_sp > XB_SPIN_CAP) { atomicAdd(&(bar)[XB_TMO], 1u); break; } } } } while (0)
struct XcdBarrier { unsigned* bar; unsigned x; volatile LAS unsigned* st; };
static __device__ unsigned g_bar[XCD_BAR_WORDS];
__device__ __forceinline__ XcdBarrier xcd_barrier_post(unsigned* bar, volatile LAS unsigned* st) {
    XcdBarrier b; b.bar = bar; b.x = xb_xcc_id(); b.st = st;
    if (threadIdx.x == 0) {
        const unsigned b0 = xb_ld(&bar[XB_XSUB(b.x)]), b1 = xb_ld(&bar[XB_XGEN(b.x)]), b2 = xb_ld(&bar[XB_TOP]), b3 = xb_ld(&bar[XB_TOPGEN]);
        st[2] = b0; st[3] = b1; st[4] = b2; st[5] = b3;
        asm volatile("s_waitcnt vmcnt(0) lgkmcnt(0)" ::: "memory");
        (void)xb_add(&bar[XB_XCNT(b.x)], 1u);
    }
    return b;
}
__device__ __forceinline__ void xcd_barrier_complete(unsigned* bar, unsigned x, unsigned& nloc, unsigned& nx) {
    const unsigned G = gridDim.x * gridDim.y * gridDim.z;
    unsigned sum, cnt, mine, sp = 0u;
    for (;;) {
        sum = 0u; cnt = 0u; mine = 0u;
#pragma unroll
        for (unsigned j = 0; j < 16; ++j) { const unsigned c = xb_ld(&bar[XB_XCNT(j)]); sum += c; cnt += (c > 0u) ? 1u : 0u; mine = (j == x) ? c : mine; }
        if (sum == G) break;
        __builtin_amdgcn_s_sleep(1);
        if ((++sp & 255u) == 0u) { if (xb_ld(&bar[XB_TMO])) break; if (sp > XB_SPIN_CAP) { atomicAdd(&bar[XB_TMO], 1u); break; } }
    }
    nloc = mine > 0u ? mine : 1u; nx = cnt > 0u ? cnt : 1u;
}
__device__ __forceinline__ void xcd_barrier(const XcdBarrier& b) {
    asm volatile("s_waitcnt vmcnt(0)" ::: "memory");
    __syncthreads();
    if (threadIdx.x == 0) {
        unsigned* bar = b.bar;
        __builtin_amdgcn_s_waitcnt(0);
        unsigned nloc = b.st[0], nx = b.st[1];
        if (nloc == 0u) { xcd_barrier_complete(bar, b.x, nloc, nx); b.st[0] = nloc; b.st[1] = nx; }
        const unsigned bs0 = b.st[2], bs1 = b.st[3], bs2 = b.st[4], bs3 = b.st[5];
        const unsigned old = xb_add(&bar[XB_XSUB(b.x)], 1u) - bs0;
        const unsigned gen = old / nloc;
        if (old + 1u == (gen + 1u) * nloc) {
            __builtin_amdgcn_fence(__ATOMIC_RELEASE, "agent");
            asm volatile("s_waitcnt vmcnt(0)" ::: "memory");
            const unsigned og = xb_add(&bar[XB_TOP], 1u) - bs2;
            const unsigned tg = og / nx;
            if (og + 1u == (tg + 1u) * nx) xb_add(&bar[XB_TOPGEN], 1u);
            else XB_SPIN(xb_ld(&bar[XB_TOPGEN]) - bs3 == tg, bar);
            __builtin_amdgcn_fence(__ATOMIC_ACQUIRE, "agent");
            xb_add(&bar[XB_XGEN(b.x)], 1u);
            asm volatile("s_waitcnt vmcnt(0)" ::: "memory");
        } else {
            XB_SPIN(xb_ld(&bar[XB_XGEN(b.x)]) - bs1 == gen, bar);
            __builtin_amdgcn_fence(__ATOMIC_ACQUIRE, "agent");
            asm volatile("s_waitcnt vmcnt(0)" ::: "memory");
        }
    }
    __syncthreads();
}

namespace ge {
constexpr int BM = 256, BK = 64, HALF = 128, HTB = HALF * BK * 2, NXCD = 8, WGM = 8;
__host__ __device__ __forceinline__ int lds_byte(int r, int c) { const int st = (r >> 4) * 2 + (c >> 5), rr = r & 15, cc = c & 31, ob = rr * 64 + cc * 2; return st * 1024 + (ob ^ (((ob >> 9) & 1) << 5)); }
__host__ __device__ __forceinline__ void stage_rc(int b, int& R, int& C) { const int st = b / 1024, sb = b % 1024, swz = sb ^ (((sb >> 9) & 1) << 5); R = (st >> 1) * 16 + swz / 64; C = (st & 1) * 32 + (swz % 64) / 2; }
__host__ __device__ __forceinline__ int lds_byte8(int r, int cb) { const int st = (r >> 4) * 2 + (cb >> 6), ob = (r & 15) * 64 + (cb & 63); return st * 1024 + (ob ^ (((ob >> 9) & 1) << 4)); }
__host__ __device__ __forceinline__ void stage_rc8(int b, int& R, int& Cb) { const int st = b / 1024, sb = b % 1024, swz = sb ^ (((sb >> 9) & 1) << 4); R = (st >> 1) * 16 + swz / 64; Cb = (st & 1) * 64 + (swz % 64); }
__host__ __device__ __forceinline__ int perm32(int rho) { const int n = rho >> 4, i = rho & 15; return 8 * (i >> 2) + 4 * n + (i & 3); }

struct Unit { int pm, pn, e, aux; };
struct Gemm { const char* A; const char* B; int lda, ldb, kb; };
constexpr int SC_W8 = 0x79797979, SC_A8 = 0x7f7f7f7f;

__device__ __forceinline__ int xcd_remap(int L, int nwg) { const int q = nwg / NXCD, r = nwg % NXCD, xcd = L % NXCD, off = L / NXCD; return (xcd < r ? xcd * (q + 1) : r * (q + 1) + (xcd - r) * q) + off; }

struct DenseSched {
    int nM, nN, nwg, G, c, lda, ldb, ksplit, akofs;
    __device__ __forceinline__ void init(int M, int N, int G_, int c_, int lda_, int ldb_, int ksplit_ = 1 << 30, int akofs_ = 0) { nM = M / BM; nN = N / BM; nwg = nM * nN; G = G_; c = c_; lda = lda_; ldb = ldb_; ksplit = ksplit_; akofs = akofs_; }
    __device__ __forceinline__ bool next(int i, Unit& u) const {
        const long L = (long)i * G + c; if (L >= nwg) return false;
        const int wgid = xcd_remap((int)L, nwg);
        const int nig = WGM * nN, gid = wgid / nig, fm = gid * WGM, gsz = (nM - fm) < WGM ? (nM - fm) : WGM;
        u.pm = fm + ((wgid % nig) % gsz); u.pn = (wgid % nig) / gsz; u.e = 0; u.aux = 0; return true;
    }
    __device__ __forceinline__ size_t a_off(const Unit& u) const { return (size_t)u.pm * BM * lda + (u.pn >= ksplit ? akofs : 0); }
    __device__ __forceinline__ size_t b_off(const Unit& u) const { return (size_t)u.pn * BM * ldb; }
    __device__ __forceinline__ unsigned a_rowoff(const Unit&, int, int r) const { return (unsigned)r * (unsigned)lda; }
};
struct MoeSched {
    const LAS int* tb; const LAS int* te; const LAS unsigned* tab; int nN, ntiles, G, c, lda, ldb, nper; bool gather;
    __device__ __forceinline__ bool next(int i, Unit& u) const {
        const int nwg = ntiles * nN; const long L = (long)i * G + c; if (L >= nwg) return false;
        const int wgid = xcd_remap((int)L, nwg);
        const int tile = wgid / nN; const int e = __builtin_amdgcn_readfirstlane(te[tile]);
        u.pm = tile; u.pn = wgid % nN; u.e = e; u.aux = tile - __builtin_amdgcn_readfirstlane(tb[e]); return true;
    }
    __device__ __forceinline__ size_t a_off(const Unit& u) const { return gather ? (size_t)0 : (size_t)u.pm * BM * lda; }
    __device__ __forceinline__ size_t b_off(const Unit& u) const { return ((size_t)u.e * nper + (size_t)u.pn * BM) * ldb; }
    __device__ __forceinline__ unsigned a_rowoff(const Unit&, int ui, int r) const { return gather ? tab[ui * 256 + r] : (unsigned)r * (unsigned)lda; }
};

template <bool FP8> __device__ __forceinline__ void ref_ld4(const char* p, float* f, float sc) {
    if constexpr (FP8) { const int w = *(const int*)p; f[0] = __builtin_amdgcn_cvt_f32_fp8(w, 0) * sc; f[1] = __builtin_amdgcn_cvt_f32_fp8(w, 1) * sc; f[2] = __builtin_amdgcn_cvt_f32_fp8(w, 2) * sc; f[3] = __builtin_amdgcn_cvt_f32_fp8(w, 3) * sc; }
    else { const u32x2 w = *(const u32x2*)p; f[0] = bf_lo(w.x) * sc; f[1] = bf_hi(w.x) * sc; f[2] = bf_lo(w.y) * sc; f[3] = bf_hi(w.y) * sc; }
}
template <int AI, bool FP8, class Epi, class Sched>
__device__ __forceinline__ void ref_half(const Gemm& g, const Sched& S, const Epi& E, const Unit& u, int ui, const char* Ab, const char* Bb, int wr, int wc, int fr, int fq) {
    constexpr int ES = FP8 ? 1 : 2;
    f32x4 acc[2][2][4][2];
#pragma unroll
    for (int a = 0; a < 2; ++a)
#pragma unroll
        for (int b = 0; b < 2; ++b)
#pragma unroll
            for (int m = 0; m < 4; ++m)
#pragma unroll
                for (int n = 0; n < 2; ++n) acc[a][b][m][n] = (f32x4){0.f, 0.f, 0.f, 0.f};
    unsigned aoff[4];
#pragma unroll
    for (int m = 0; m < 4; ++m) aoff[m] = S.a_rowoff(u, ui, AI * HALF + wr * 64 + m * 16 + fr);
    for (int khalf = 0; khalf < 2; ++khalf) {
    if constexpr (Epi::HAS_MID) { if (khalf == 1) E.template mid<AI, AI + 1>(acc, u, wr, wc, fr, fq); }
#pragma unroll
    for (int bj = 0; bj < 2; ++bj)
#pragma unroll
        for (int n = 0; n < 2; ++n) {
            const char* Bc = Bb + (size_t)(bj * HALF + wc * 32 + (Epi::PERM ? 8 * fq + 4 * n : 16 * n + 4 * fq)) * g.ldb;
            for (int kbyte = khalf * (g.kb / 2); kbyte < (khalf + 1) * (g.kb / 2); kbyte += 4 * ES) {
                float af[4][4];
#pragma unroll
                for (int r = 0; r < 4; ++r) ref_ld4<FP8>(Ab + aoff[r] + kbyte, af[r], 1.0f);
#pragma unroll
                for (int i = 0; i < 4; ++i) {
                    float bf[4]; ref_ld4<FP8>(Bc + (size_t)i * g.ldb + kbyte, bf, 1.0f);
#pragma unroll
                    for (int m = 0; m < 4; ++m) { float s = acc[AI][bj][m][n][i];
                        s = fmaf(af[m][0], bf[0], s); s = fmaf(af[m][1], bf[1], s); s = fmaf(af[m][2], bf[2], s); s = fmaf(af[m][3], bf[3], s);
                        acc[AI][bj][m][n][i] = s; }
                }
            }
        }
    }
    E.template run<AI, AI + 1>(acc, u, wr, wc, fr, fq);
}
template <class Epi, class Sched, bool FP8>
__device__ __forceinline__ void gemm_phase_ref(const Gemm g, const Sched& S, const Epi& E) {
    const int tid = threadIdx.x, wid = tid >> 6, lane = tid & 63, wr = wid >> 2, wc = wid & 3, fr = lane & 15, fq = lane >> 4;
    Unit u;
    for (int ui = 0; S.next(ui, u); ++ui) {
        const char* Ab = g.A + S.a_off(u); const char* Bb = g.B + S.b_off(u);
        ref_half<0, FP8, Epi, Sched>(g, S, E, u, ui, Ab, Bb, wr, wc, fr, fq);
        ref_half<1, FP8, Epi, Sched>(g, S, E, u, ui, Ab, Bb, wr, wc, fr, fq);
    }
}

template <class Epi, class Sched, bool GATHER, bool FP8>
__device__ __forceinline__ void gemm_phase_fast(LAS unsigned char* lds, const Gemm g, const Sched& S, const Epi& E) {
    const int tid = threadIdx.x, wid = __builtin_amdgcn_readfirstlane(tid >> 6), lane = tid & 63, wr = wid >> 2, wc = wid & 3, fr = lane & 15, fq = lane >> 4;
    const int nt = g.kb / 128;
    unsigned voffA[2], voffB[2]; int RA[2], CA2[2];
#pragma unroll
    for (int i = 0; i < 2; ++i) { int R, C2;
        if constexpr (FP8) stage_rc8(tid * 16 + i * 8192, R, C2); else { int C; stage_rc(tid * 16 + i * 8192, R, C); C2 = C * 2; }
        const int Rb = Epi::PERM ? ((R & ~31) + perm32(R & 31)) : R;
        voffA[i] = (unsigned)(R * g.lda + C2); voffB[i] = (unsigned)(Rb * g.ldb + C2); RA[i] = R; CA2[i] = C2; }
    const size_t kstep = (size_t)(BK * 2);
    const size_t hstepA = (size_t)HALF * g.lda, hstepB = (size_t)HALF * g.ldb;
    const unsigned ldsw = (unsigned)wid * 1024u;
    const int aoff = FP8 ? lds_byte8(wr * 64 + fr, fq * 32) : lds_byte(wr * 64 + fr, fq * 8), boff = FP8 ? lds_byte8(wc * 32 + fr, fq * 32) : lds_byte(wc * 32 + fr, fq * 8);
    const int aoff2 = aoff ^ 16, boff2 = boff ^ 16;
#define PG8_SA(b, h) (((b) * 2 + (h)) * HTB)
#define PG8_SB(b, h) ((4 + (b) * 2 + (h)) * HTB)
#define PG8_GLDS(src, bufoff, i_) __builtin_amdgcn_global_load_lds((const unsigned*)(src), (LAS unsigned*)(lds + (bufoff) + ldsw + (i_) * 8192), 16, 0, 0)
#define PG8_STAGE_B(bufoff, p, h) do { _Pragma("unroll") for (int _i = 0; _i < 2; ++_i) PG8_GLDS((const char*)(p) + (h) * hstepB + voffB[_i], bufoff, _i); } while (0)
#define PG8_STAGE_A(bufoff, p, h, NX) do { _Pragma("unroll") for (int _i = 0; _i < 2; ++_i) { \
        if constexpr (GATHER) PG8_GLDS((const char*)(p) + ((NX) ? gvN[h][_i] : gvC[h][_i]), bufoff, _i); \
        else PG8_GLDS((const char*)(p) + (h) * hstepA + voffA[_i], bufoff, _i); } } while (0)
#define PG8_LDA(dst, b, h) do { _Pragma("unroll") for (int m = 0; m < 4; ++m) { \
        if constexpr (FP8) { const u32x4 lo_ = *(const LAS u32x4*)(lds + PG8_SA(b, h) + aoff + m * 2048), hi_ = *(const LAS u32x4*)(lds + PG8_SA(b, h) + aoff2 + m * 2048); \
            dst##8[m] = (v8i){(int)lo_.x, (int)lo_.y, (int)lo_.z, (int)lo_.w, (int)hi_.x, (int)hi_.y, (int)hi_.z, (int)hi_.w}; } \
        else { _Pragma("unroll") for (int k = 0; k < 2; ++k) dst[m][k] = *(const LAS bf16x8*)(lds + PG8_SA(b, h) + aoff + m * 2048 + k * 1024); } } } while (0)
#define PG8_LDB(dst, b, h) do { _Pragma("unroll") for (int n = 0; n < 2; ++n) { \
        if constexpr (FP8) { const u32x4 lo_ = *(const LAS u32x4*)(lds + PG8_SB(b, h) + boff + n * 2048), hi_ = *(const LAS u32x4*)(lds + PG8_SB(b, h) + boff2 + n * 2048); \
            dst##8[n] = (v8i){(int)lo_.x, (int)lo_.y, (int)lo_.z, (int)lo_.w, (int)hi_.x, (int)hi_.y, (int)hi_.z, (int)hi_.w}; } \
        else { _Pragma("unroll") for (int k = 0; k < 2; ++k) dst[n][k] = *(const LAS bf16x8*)(lds + PG8_SB(b, h) + boff + n * 2048 + k * 1024); } } } while (0)
#define PG8_MMA(ai, bj, At, Bt) do { __builtin_amdgcn_s_setprio(1); _Pragma("unroll") for (int m = 0; m < 4; ++m) _Pragma("unroll") for (int n = 0; n < 2; ++n) { \
        if constexpr (FP8) asm volatile("v_mfma_f32_16x16x128_f8f6f4 %0, %1, %2, %0" : "+v"(acc[ai][bj][m][n]) : "v"(Bt##8[n]), "v"(At##8[m])); \
        else { _Pragma("unroll") for (int k = 0; k < 2; ++k) acc[ai][bj][m][n] = __builtin_amdgcn_mfma_f32_16x16x32_bf16(Bt[n][k], At[m][k], acc[ai][bj][m][n], 0, 0, 0); } } \
        __builtin_amdgcn_s_setprio(0); } while (0)
#define PG8_WAIT_V(n) asm volatile("s_waitcnt vmcnt(" #n ")" ::: "memory")
#define PG8_WAIT_L(n) asm volatile("s_waitcnt lgkmcnt(" #n ")" ::: "memory")
#define PG8_BAR __builtin_amdgcn_s_barrier()
#define PG8_SCHED __builtin_amdgcn_sched_barrier(0)
#define PG8_RP(n) do { if constexpr (FP8) __builtin_amdgcn_s_setprio(n); } while (0)
    Unit cur, nxt; int ui = 0;
    if (!S.next(0, cur)) return;
    f32x4 acc[2][2][4][2];
#pragma unroll
    for (int a = 0; a < 2; ++a)
#pragma unroll
        for (int b = 0; b < 2; ++b)
#pragma unroll
            for (int m = 0; m < 4; ++m)
#pragma unroll
                for (int n = 0; n < 2; ++n) acc[a][b][m][n] = (f32x4){0.f, 0.f, 0.f, 0.f};
    bf16x8 At[4][2], B0[2][2], B1[2][2]; v8i At8[4], B08[2], B18[2];
    unsigned gvC[2][2], gvN[2][2];
#pragma unroll
    for (int h = 0; h < 2; ++h)
#pragma unroll
        for (int i = 0; i < 2; ++i) { gvC[h][i] = GATHER ? S.a_rowoff(cur, 0, h * HALF + RA[i]) + (unsigned)CA2[i] : 0u; gvN[h][i] = gvC[h][i]; }
    const char* cA = g.A + S.a_off(cur); const char* cB = g.B + S.b_off(cur);
    PG8_STAGE_B(PG8_SB(0, 0), cB, 0); PG8_STAGE_B(PG8_SB(0, 1), cB, 1); PG8_STAGE_A(PG8_SA(0, 0), cA, 0, false); PG8_STAGE_A(PG8_SA(0, 1), cA, 1, false);
    if (wr == 1) PG8_BAR;
    PG8_WAIT_V(2); PG8_BAR;
    PG8_STAGE_B(PG8_SB(1, 0), cB + kstep, 0); PG8_STAGE_A(PG8_SA(1, 0), cA + kstep, 0, false); PG8_STAGE_B(PG8_SB(1, 1), cB + kstep, 1);
    PG8_WAIT_V(6); PG8_BAR;
    for (;;) {
        const bool has_next = S.next(ui + 1, nxt);
        const char* nA = has_next ? g.A + S.a_off(nxt) : cA; const char* nB = has_next ? g.B + S.b_off(nxt) : cB;
        if constexpr (GATHER) { if (has_next) {
#pragma unroll
            for (int h = 0; h < 2; ++h)
#pragma unroll
                for (int i = 0; i < 2; ++i) gvN[h][i] = S.a_rowoff(nxt, ui + 1, h * HALF + RA[i]) + (unsigned)CA2[i]; } }
#pragma unroll 1
        for (int t = 0; t < nt; t += 2) {
            if constexpr (Epi::HAS_MID) { if (t * 2 == nt) { int fr_ = fr, fq_ = fq; asm volatile("" : "+v"(fr_), "+v"(fq_)); E.template mid<0, 2>(acc, cur, wr, wc, fr_, fq_); } }
            asm volatile("" : "+v"(voffA[0]), "+v"(voffA[1]), "+v"(voffB[0]), "+v"(voffB[1]));
            const bool last = (t == nt - 2);
            const char* a1 = cA + (size_t)(t + 1) * kstep;
            const char* a2 = last ? nA : cA + (size_t)(t + 2) * kstep; const char* b2 = last ? nB : cB + (size_t)(t + 2) * kstep;
            const char* a3 = a2 + kstep; const char* b3 = b2 + kstep;
            PG8_RP(2); PG8_LDB(B0, 0, 0); PG8_LDB(B1, 0, 1); PG8_SCHED; PG8_LDA(At, 0, 0); PG8_STAGE_A(PG8_SA(1, 1), a1, 1, false);
            PG8_RP(0); PG8_WAIT_V(8); PG8_WAIT_L(0); PG8_BAR; PG8_MMA(0, 0, At, B0); PG8_MMA(0, 1, At, B1); PG8_BAR; PG8_SCHED;
            PG8_RP(2); PG8_LDA(At, 0, 1); PG8_STAGE_B(PG8_SB(0, 0), b2, 0); PG8_STAGE_B(PG8_SB(0, 1), b2, 1); PG8_STAGE_A(PG8_SA(0, 0), a2, 0, last);
            PG8_RP(0); PG8_WAIT_V(8); PG8_WAIT_L(0); PG8_BAR; PG8_MMA(1, 0, At, B0); PG8_MMA(1, 1, At, B1); PG8_BAR; PG8_SCHED;
            PG8_RP(2); PG8_LDB(B0, 1, 0); PG8_LDB(B1, 1, 1); PG8_SCHED; PG8_LDA(At, 1, 0); PG8_STAGE_A(PG8_SA(0, 1), a2, 1, last);
            PG8_RP(0); PG8_WAIT_V(8); PG8_WAIT_L(0); PG8_BAR; PG8_MMA(0, 0, At, B0); PG8_MMA(0, 1, At, B1); PG8_BAR; PG8_SCHED;
            PG8_RP(2); PG8_LDA(At, 1, 1); PG8_STAGE_B(PG8_SB(1, 0), b3, 0); PG8_STAGE_B(PG8_SB(1, 1), b3, 1); PG8_STAGE_A(PG8_SA(1, 0), a3, 0, last);
            PG8_RP(0); PG8_WAIT_V(8); PG8_WAIT_L(0); PG8_BAR; PG8_MMA(1, 0, At, B0); PG8_MMA(1, 1, At, B1); PG8_BAR; PG8_SCHED;
        }
        if (wr == 0) PG8_BAR;
        if constexpr (FP8) asm volatile("s_nop 15\n\ts_nop 7" ::: "memory");
        { int fr_ = fr, fq_ = fq; asm volatile("" : "+v"(fr_), "+v"(fq_));
          E.template run<0, 2>(acc, cur, wr, wc, fr_, fq_); }
        if (!has_next) break;
#pragma unroll
        for (int a = 0; a < 2; ++a)
#pragma unroll
            for (int b = 0; b < 2; ++b)
#pragma unroll
                for (int m = 0; m < 4; ++m)
#pragma unroll
                    for (int n = 0; n < 2; ++n) acc[a][b][m][n] = (f32x4){0.f, 0.f, 0.f, 0.f};
        cur = nxt; cA = nA; cB = nB; ++ui;
        if constexpr (GATHER) {
#pragma unroll
            for (int h = 0; h < 2; ++h)
#pragma unroll
                for (int i = 0; i < 2; ++i) gvC[h][i] = gvN[h][i]; }
        if (wr == 1) PG8_BAR;
    }
    PG8_WAIT_V(0);
    PG8_BAR;
#undef PG8_SA
#undef PG8_SB
#undef PG8_GLDS
#undef PG8_STAGE_A
#undef PG8_STAGE_B
#undef PG8_LDA
#undef PG8_LDB
#undef PG8_MMA
#undef PG8_WAIT_V
#undef PG8_WAIT_L
#undef PG8_BAR
#undef PG8_SCHED
#undef PG8_RP
}
}

using ge::Unit;
#define EPI_ROW(ai, m) ((ai) * 128 + wr * 64 + (m) * 16 + fr)
struct EpiInProj {
    static constexpr bool PERM = true, HAS_MID = false;
    bf16_t *LAT, *VC, *BG, *SG;
    float *RSQ, *RSKV; const float *CS, *SN; bf16_t* K; LAS float* red;
    template <int A0, int A1> __device__ __forceinline__ void run(const f32x4 (&acc)[2][2][4][2], const Unit& u, int wr, int wc, int fr, int fq) const {
        const int pn = u.pn;
        if constexpr (A0 == 0 && A1 == 2) { if (pn < 2) {
            const int t_ = threadIdx.x;
            if (t_ < 256) red[t_] = 0.f;
            asm volatile("s_waitcnt lgkmcnt(0)" ::: "memory"); __builtin_amdgcn_s_barrier(); asm volatile("" ::: "memory");
#pragma unroll
            for (int ai = 0; ai < 2; ++ai)
#pragma unroll
                for (int m = 0; m < 4; ++m) { float ps = 0.f;
#pragma unroll
                    for (int n = 0; n < 2; ++n)
#pragma unroll
                        for (int i = 0; i < 4; ++i) { const float v0 = acc[ai][0][m][n][i], v1 = acc[ai][1][m][n][i]; ps += v0 * v0 + (pn == 0 ? v1 * v1 : 0.f); }
                    ps += __shfl_xor(ps, 16); ps += __shfl_xor(ps, 32);
                    if (fq == 0) __hip_atomic_fetch_add(red + EPI_ROW(ai, m), ps, __ATOMIC_RELAXED, __HIP_MEMORY_SCOPE_WORKGROUP); }
            asm volatile("s_waitcnt lgkmcnt(0)" ::: "memory"); __builtin_amdgcn_s_barrier(); asm volatile("" ::: "memory");
            if (t_ < 256) { const float s_ = red[t_]; if (pn == 0) RSQ[(size_t)u.pm * 256 + t_] = 1.0f / sqrtf(s_ * (1.0f / 256.0f) + RMS_EPS); else RSKV[(size_t)u.pm * 256 + t_] = 1.0f / sqrtf(s_ * (1.0f / 128.0f) + RMS_EPS); }
            if (pn == 1 && wc == 0) {
#pragma unroll
                for (int ai = 0; ai < 2; ++ai)
#pragma unroll
                    for (int m = 0; m < 4; ++m) { const size_t row = (size_t)u.pm * 256 + EPI_ROW(ai, m); const int j0 = 8 * (fq & 1);
                        f32x4 o2[2];
#pragma unroll
                        for (int n = 0; n < 2; ++n) { const f32x4 cs = *(const f32x4*)(CS + row * 16 + j0 + 4 * n), sn = *(const f32x4*)(SN + row * 16 + j0 + 4 * n);
#pragma unroll
                            for (int i = 0; i < 4; ++i) { const float v = acc[ai][1][m][n][i], oth = __shfl_xor(v, 32); o2[n][i] = fq < 2 ? v * cs[i] - oth * sn[i] : oth * sn[i] + v * cs[i]; } }
                        const u32x4 w = pack8(o2[0], o2[1]);
#pragma unroll
                        for (int h = 0; h < NH; ++h) *(u32x4*)(K + row * 1024 + h * 128 + 64 + 8 * fq) = w; }
            }
        } }
#pragma unroll
        for (int ai = A0; ai < A1; ++ai)
#pragma unroll
            for (int m = 0; m < 4; ++m) {
                const size_t row = (size_t)u.pm * 256 + EPI_ROW(ai, m);
                if (pn >= 2 && pn < 6) {
                    const int lc = wc * 32 + 8 * fq;
                    *(u32x4*)(VC + row * 512 + 128 * (pn - 2) + lc) = pack8(acc[ai][0][m][0] * acc[ai][1][m][0], acc[ai][0][m][1] * acc[ai][1][m][1]);
                } else {
#pragma unroll
                    for (int bj = 0; bj < 2; ++bj) {
                        const int lc = bj * 128 + wc * 32 + 8 * fq; const f32x4 v0 = acc[ai][bj][m][0], v1 = acc[ai][bj][m][1];
                        if (pn < 2) *(u32x4*)(LAT + row * 512 + 256 * pn + lc) = pack8(v0, v1);
                        else if (pn < 8) *(u32x4*)(BG + row * 512 + 256 * (pn - 6) + lc) = pack8(v0, v1);
                        else { f32x4 s0, s1;
#pragma unroll
                            for (int i = 0; i < 4; ++i) { s0[i] = fast_sigmoid(v0[i]); s1[i] = fast_sigmoid(v1[i]); }
                            *(u32x2*)((unsigned char*)SG + row * 2048 + 256 * (pn - 8) + lc) = pack8_u8(s0, s1); }
                    }
                }
            }
    }
};
struct EpiUp {
    static constexpr bool PERM = false, HAS_MID = false;
    bf16_t *Q, *K, *V; const float *RSQ, *RSKV, *CS, *SN;
    template <int RB, int A0, int A1> __device__ __forceinline__ void runq(const f32x4 (&acc)[2][2][4][2], const Unit& u, int wr, int wc, int fr, int fq) const {
        const int pn = u.pn;
        float rs[2][4]; f32x4 cs[2][4], sn[2][4];
#pragma unroll
        for (int ai = A0; ai < A1; ++ai)
#pragma unroll
            for (int m = 0; m < 4; ++m) rs[ai][m] = RSQ[(unsigned)(u.pm * 256 + EPI_ROW(ai, m))];
#pragma unroll
        for (int ai = A0; ai < A1; ++ai) {
            if constexpr (RB >= 0) {
#pragma unroll
                for (int m = 0; m < 4; ++m) { const unsigned row = (unsigned)(u.pm * 256 + EPI_ROW(ai, m)); cs[ai][m] = *(const f32x4*)(CS + (row * 16u + 4u * (unsigned)fq)); sn[ai][m] = *(const f32x4*)(SN + (row * 16u + 4u * (unsigned)fq)); }
                asm volatile("" ::: "memory");
            }
#pragma unroll
            for (int m = 0; m < 4; ++m) {
                const unsigned row = (unsigned)(u.pm * 256 + EPI_ROW(ai, m));
#pragma unroll
                for (int bj = 0; bj < 2; ++bj) {
                    const unsigned lc = (unsigned)(256 * pn + bj * 128 + wc * 32 + 4 * fq);
                    f32x4 x1 = acc[ai][bj][m][0] * rs[ai][m], x2 = acc[ai][bj][m][1] * rs[ai][m];
                    if constexpr (RB >= 0) if (bj == RB) { const f32x4 o1 = x1 * cs[ai][m] - x2 * sn[ai][m], o2 = x1 * sn[ai][m] + x2 * cs[ai][m]; x1 = o1; x2 = o2; }
                    x1 = x1 * QSCALE; x2 = x2 * QSCALE;
                    *(u32x2*)(Q + (row * 768u + lc)) = pack4(x1); *(u32x2*)(Q + (row * 768u + lc + 16u)) = pack4(x2);
                }
            }
            asm volatile("" ::: "memory");
        }
    }
    template <int A0, int A1> __device__ __forceinline__ void run(const f32x4 (&acc)[2][2][4][2], const Unit& u, int wr, int wc, int fr, int fq) const {
        const int pn = u.pn;
        if (pn < 3) {
            const int g0 = (8 * pn + wc) % 3;
            if (g0 == 2) runq<0, A0, A1>(acc, u, wr, wc, fr, fq); else if (g0 == 1) runq<1, A0, A1>(acc, u, wr, wc, fr, fq); else runq<-1, A0, A1>(acc, u, wr, wc, fr, fq);
        } else {
            float rs[2][4];
#pragma unroll
            for (int ai = A0; ai < A1; ++ai)
#pragma unroll
                for (int m = 0; m < 4; ++m) rs[ai][m] = RSKV[(unsigned)(u.pm * 256 + EPI_ROW(ai, m))];
#pragma unroll
            for (int ai = A0; ai < A1; ++ai)
#pragma unroll
                for (int m = 0; m < 4; ++m) {
                    const unsigned row = (unsigned)(u.pm * 256 + EPI_ROW(ai, m));
#pragma unroll
                    for (int bj = 0; bj < 2; ++bj)
#pragma unroll
                        for (int n = 0; n < 2; ++n) {
                            const unsigned lc = (unsigned)(bj * 128 + wc * 32 + 16 * n + 4 * fq); const f32x4 v = acc[ai][bj][m][n] * rs[ai][m];
                            if (pn < 5) { const unsigned c = 256u * (unsigned)(pn - 3) + lc; *(u32x2*)(K + (row * 1024u + (c >> 6) * 128u + (c & 63u))) = pack4(v); }
                            else *(u32x2*)(V + (row * 512u + 256u * (unsigned)(pn - 5) + lc)) = pack4(v);
                        }
                }
        }
    }
};
template <int STEP> struct EpiBranch {
    static constexpr bool PERM = true, HAS_MID = false;
    const bf16_t* SG; bf16_t* TMP; bf16_t* MRG;
    template <int A0, int A1> __device__ __forceinline__ void run(const f32x4 (&acc)[2][2][4][2], const Unit& u, int wr, int wc, int fr, int fq) const {
#pragma unroll
        for (int ai = A0; ai < A1; ++ai)
#pragma unroll
            for (int m = 0; m < 4; ++m) {
                const size_t row = (size_t)u.pm * 256 + EPI_ROW(ai, m);
#pragma unroll
                for (int bj = 0; bj < 2; ++bj) {
                    const int col = 256 * u.pn + bj * 128 + wc * 32 + 8 * fq;
                    float sg[8]; unpack8(*(const u32x4*)(SG + row * 2048 + (STEP ? 1024 : 0) + col), sg);
                    f32x4 r0, r1;
#pragma unroll
                    for (int i = 0; i < 4; ++i) { r0[i] = sg[i] * acc[ai][bj][m][0][i]; r1[i] = sg[4 + i] * acc[ai][bj][m][1][i]; }
                    if (STEP == 0) *(u32x4*)(TMP + row * 1024 + col) = pack8(r0, r1);
                    else { float t[8]; unpack8(*(const u32x4*)(TMP + row * 1024 + col), t);
#pragma unroll
                        for (int i = 0; i < 4; ++i) { r0[i] += t[i]; r1[i] += t[4 + i]; }
                        *(u32x4*)(MRG + row * 1024 + col) = pack8(r0, r1); }
                }
            }
    }
};
struct EpiMerged {
    static constexpr bool PERM = true, HAS_MID = true;
    const bf16_t* SG; bf16_t* MRG;
    template <int A0, int A1> __device__ __forceinline__ void mid(f32x4 (&acc)[2][2][4][2], const Unit& u, int wr, int wc, int fr, int fq) const {
#pragma unroll
        for (int ai = A0; ai < A1; ++ai)
#pragma unroll
            for (int m = 0; m < 4; ++m) {
                const size_t row = (size_t)u.pm * 256 + EPI_ROW(ai, m);
#pragma unroll
                for (int bj = 0; bj < 2; ++bj) {
                    const int col = 256 * u.pn + bj * 128 + wc * 32 + 8 * fq;
                    float sa[8], sc[8]; unpack8_u8(*(const u32x2*)((const unsigned char*)SG + row * 2048 + col), sa); unpack8_u8(*(const u32x2*)((const unsigned char*)SG + row * 2048 + 1024 + col), sc);
#pragma unroll
                    for (int i = 0; i < 4; ++i) { acc[ai][bj][m][0][i] *= sa[i] * __builtin_amdgcn_rcpf(sc[i]); acc[ai][bj][m][1][i] *= sa[4 + i] * __builtin_amdgcn_rcpf(sc[4 + i]); }
                }
            }
    }
    template <int A0, int A1> __device__ __forceinline__ void run(const f32x4 (&acc)[2][2][4][2], const Unit& u, int wr, int wc, int fr, int fq) const {
#pragma unroll
        for (int ai = A0; ai < A1; ++ai)
#pragma unroll
            for (int m = 0; m < 4; ++m) {
                const size_t row = (size_t)u.pm * 256 + EPI_ROW(ai, m);
#pragma unroll
                for (int bj = 0; bj < 2; ++bj) {
                    const int col = 256 * u.pn + bj * 128 + wc * 32 + 8 * fq;
                    float sc[8]; unpack8_u8(*(const u32x2*)((const unsigned char*)SG + row * 2048 + 1024 + col), sc);
                    f32x4 r0, r1;
#pragma unroll
                    for (int i = 0; i < 4; ++i) { r0[i] = (sc[i] * (1.0f / 255.0f)) * acc[ai][bj][m][0][i]; r1[i] = (sc[4 + i] * (1.0f / 255.0f)) * acc[ai][bj][m][1][i]; }
                    *(u32x4*)(MRG + row * 1024 + col) = pack8(r0, r1);
                }
            }
    }
};
struct EpiWo {
    static constexpr bool PERM = false, HAS_MID = false;
    const float* X; const float* ADA; bf16_t* X1;
    template <int A0, int A1> __device__ __forceinline__ void run(const f32x4 (&acc)[2][2][4][2], const Unit& u, int wr, int wc, int fr, int fq) const {
#pragma unroll
        for (int ai = A0; ai < A1; ++ai)
#pragma unroll
            for (int m = 0; m < 4; ++m) {
                const size_t row = (size_t)u.pm * 256 + EPI_ROW(ai, m); const int b = (int)(row >> 12);
#pragma unroll
                for (int bj = 0; bj < 2; ++bj)
#pragma unroll
                    for (int n = 0; n < 2; ++n) {
                        const int col = 256 * u.pn + bj * 128 + wc * 32 + 16 * n + 4 * fq;
                        const f32x4 xv = *(const f32x4*)(X + row * 1024 + col), gm = *(const f32x4*)(ADA + b * 6144 + 2048 + col);
                        *(u32x2*)(X1 + row * 1024 + col) = pack4(xv + gm * acc[ai][bj][m][n]);
                    }
            }
    }
};
struct EpiGU {
    static constexpr bool PERM = true, HAS_MID = false;
    const float* BGU; unsigned char* ACT;
    template <int A0, int A1> __device__ __forceinline__ void run(const f32x4 (&acc)[2][2][4][2], const Unit& u, int wr, int wc, int fr, int fq) const {
        const int col = 128 * u.pn + wc * 32 + 8 * fq;
        f32x4 bg[2], bu[2];
#pragma unroll
        for (int n = 0; n < 2; ++n) { bg[n] = *(const f32x4*)(BGU + (size_t)u.e * 2048 + col + 4 * n); bu[n] = *(const f32x4*)(BGU + (size_t)u.e * 2048 + 1024 + col + 4 * n); }
#pragma unroll
        for (int ai = A0; ai < A1; ++ai)
#pragma unroll
            for (int m = 0; m < 4; ++m) {
                const size_t row = (size_t)u.pm * 256 + EPI_ROW(ai, m);
                f32x4 r[2];
#pragma unroll
                for (int n = 0; n < 2; ++n)
#pragma unroll
                    for (int i = 0; i < 4; i += 2) {
                        typedef float f32x2 __attribute__((ext_vector_type(2)));
                        f32x2 gt = (f32x2){acc[ai][0][m][n][i], acc[ai][0][m][n][i + 1]} * W8S + (f32x2){bg[n][i], bg[n][i + 1]};
                        f32x2 up = (f32x2){acc[ai][1][m][n][i], acc[ai][1][m][n][i + 1]} * W8S + (f32x2){bu[n][i], bu[n][i + 1]};
                        gt = __builtin_elementwise_min(gt, (f32x2){7.0f, 7.0f});
                        up = __builtin_elementwise_min(__builtin_elementwise_max(up, (f32x2){-7.0f, -7.0f}), (f32x2){7.0f, 7.0f});
                        const f32x2 t = gt * (-1.702f * 1.4426950408889634f);
                        f32x2 d; d.x = __builtin_amdgcn_exp2f(t.x); d.y = __builtin_amdgcn_exp2f(t.y); d = d + 1.0f;
                        f32x2 q; q.x = __builtin_amdgcn_rcpf(d.x); q.y = __builtin_amdgcn_rcpf(d.y);
                        const f32x2 sg = gt * q, res = up * sg + sg;
                        r[n][i] = res.x; r[n][i + 1] = res.y;
                    }
                if (MOE_FP8) *(u32x2*)(ACT + row * 1024 + col) = pack8_fp8(r[0], r[1]);
                else *(u32x4*)(ACT + (row * 1024 + col) * 2) = pack8(r[0], r[1]);
            }
    }
};
struct EpiDown {
    static constexpr bool PERM = true, HAS_MID = false;
    const float* BD; const int* RFLAT; const LAS int* CNT; unsigned char* Y;
    template <int A0, int A1> __device__ __forceinline__ void run(const f32x4 (&acc)[2][2][4][2], const Unit& u, int wr, int wc, int fr, int fq) const {
        const int cnt = CNT[u.e];
        f32x4 bv[2][2];
#pragma unroll
        for (int bj = 0; bj < 2; ++bj)
#pragma unroll
            for (int n = 0; n < 2; ++n) bv[bj][n] = *(const f32x4*)(BD + (size_t)u.e * 1024 + 256 * u.pn + bj * 128 + wc * 32 + 8 * fq + 4 * n);
#pragma unroll
        for (int ai = A0; ai < A1; ++ai)
#pragma unroll
            for (int m = 0; m < 4; ++m) {
                const int rr = u.aux * 256 + EPI_ROW(ai, m);
                if (rr < cnt) {
                    const size_t f = (size_t)RFLAT[(size_t)u.e * ECAP + rr];
#pragma unroll
                    for (int bj = 0; bj < 2; ++bj) {
                        const int col = 256 * u.pn + bj * 128 + wc * 32 + 8 * fq;
                        const f32x4 y0 = acc[ai][bj][m][0] * W8S + bv[bj][0], y1 = acc[ai][bj][m][1] * W8S + bv[bj][1];
                        if (Y_FP8) *(u32x2*)(Y + f * 1024 + col) = pack8_fp8(y0 * 16.0f, y1 * 16.0f); else *(u32x4*)(Y + (f * 1024 + col) * 2) = pack8(y0, y1);
                    }
                }
            }
    }
};

template <bool FAST, bool GATHER, bool FP8, class Epi, class Sched>
__device__ __forceinline__ void run_gemm(LAS unsigned char* lds, const ge::Gemm g, const Sched& S, const Epi& E) {
    if constexpr (FAST) ge::gemm_phase_fast<Epi, Sched, GATHER, FP8>(lds, g, S, E);
    else ge::gemm_phase_ref<Epi, Sched, FP8>(g, S, E);
}

struct Args { const void* in[23]; float* out; unsigned char* ws; int ph_lo, ph_hi, li, pad; };
typedef const __attribute__((address_space(4))) unsigned char* kptr_t;
struct KA { kptr_t kp; unsigned char* ws; float* out;
    __device__ __forceinline__ const void* in(int i) const { return *(const void* const volatile __attribute__((address_space(4)))*)(kp + 8 * i); } };
enum { I_X = 0, I_C, I_POS, I_WADA, I_BADA, I_GMIX, I_WIN, I_GQ, I_WUQ, I_GKV, I_WUKV, I_WA, I_CONVW, I_WC, I_WO, I_GFFN, I_RW, I_RB, I_WGU, I_BGU, I_WD, I_BD, I_GFIN };

template <bool FP8> __device__ __forceinline__ void p0_item(const float* W, int N, int k0, int n0, bf16_t* WT, int ldk, int drow0, const float* gsc, LAS float* scr, int lane) {
#pragma unroll 8
    for (int i = 0; i < 32; ++i) { const int kk = 2 * i + (lane >> 5); scr[kk * 33 + (lane & 31)] = W[(size_t)(k0 + kk) * N + n0 + (lane & 31)]; }
    LDS_WAIT(); asm volatile("" ::: "memory");
    const int c = lane & 7;
    float gs[8];
#pragma unroll
    for (int t = 0; t < 8; ++t) gs[t] = gsc ? gsc[k0 + 8 * c + t] : 1.0f;
#pragma unroll
    for (int j = 0; j < 4; ++j) { const int n = (lane >> 3) + 8 * j; const LAS float* s = scr + (8 * c) * 33 + n;
        u32x4 o; o.x = cvt_pk_bf16(s[0 * 33] * gs[0], s[1 * 33] * gs[1]); o.y = cvt_pk_bf16(s[2 * 33] * gs[2], s[3 * 33] * gs[3]);
        o.z = cvt_pk_bf16(s[4 * 33] * gs[4], s[5 * 33] * gs[5]); o.w = cvt_pk_bf16(s[6 * 33] * gs[6], s[7 * 33] * gs[7]);
        if constexpr (FP8) { f32x4 a = {s[0 * 33], s[1 * 33], s[2 * 33], s[3 * 33]}, b = {s[4 * 33], s[5 * 33], s[6 * 33], s[7 * 33]};
            *(u32x2*)((unsigned char*)WT + (size_t)(drow0 + n) * ldk + k0 + 8 * c) = pack8_fp8(a * 64.0f, b * 64.0f); }
        else *(u32x4*)(WT + (size_t)(drow0 + n) * ldk + k0 + 8 * c) = o; }
    LDS_WAIT(); asm volatile("" ::: "memory");
}
struct BigItem { const float* W; int N, k0, n0, dA, dB; unsigned char* WT8; };
__device__ __forceinline__ BigItem big_item(const KA& a, int it) {
    BigItem b; const int e = it / 96, r = it % 96;
    if (r < 64) { const int kb = r >> 3, nb = r & 7, n0 = 256 * nb;
        b.W = (const float*)a.in(I_WGU) + (size_t)e * 1024 * 2048; b.N = 2048; b.k0 = 128 * kb; b.n0 = n0; b.WT8 = a.ws + WS_WGU + (size_t)e * 2048 * 1024;
        b.dA = n0 < 1024 ? (n0 >> 7) * 256 : ((n0 - 1024) >> 7) * 256 + 128; b.dB = n0 < 1024 ? ((n0 >> 7) + 1) * 256 : (((n0 - 1024) >> 7) + 1) * 256 + 128; }
    else { const int q = r - 64, kb = q >> 2, nb = q & 3;
        b.W = (const float*)a.in(I_WD) + (size_t)e * 1024 * 1024; b.N = 1024; b.k0 = 128 * kb; b.n0 = 256 * nb; b.WT8 = a.ws + WS_WD + (size_t)e * 1024 * 1024; b.dA = 256 * nb; b.dB = 256 * nb + 128; }
    return b;
}
constexpr int CONV_IN_ITEMS = 2048, CONV_SLICES = 4 * CONV_IN_ITEMS;
__device__ __forceinline__ void glds16_nt(const void* gsrc, unsigned lds_dst) {
    unsigned keep;
    asm volatile("s_mov_b32 %0, m0\n\ts_mov_b32 m0, %2\n\ts_nop 0\n\tglobal_load_lds_dwordx4 %1, off nt\n\ts_mov_b32 m0, %0" : "=&s"(keep) : "v"(gsrc), "s"(lds_dst) : "memory");
}
struct ConvCtx { int c, r, s0, ns; };
constexpr int CONV_SLOT = 32 * 1040;
#define CONV_DMA() do { const bool on_ = cx.c < cx.ns; const int sl_ = cx.s0 + cx.c; const BigItem cs_ = big_item(a, on_ ? sl_ >> 2 : 0);   \
        const float* p_ = cs_.W + (on_ ? (size_t)(cs_.k0 + 32 * (sl_ & 3) + wid) * cs_.N + cs_.n0 : (size_t)0) + 4 * lane; const size_t st_ = on_ ? (size_t)8 * cs_.N : (size_t)0; \
        LAS unsigned char* d_ = Cs + (cx.c & 1) * CONV_SLOT + wid * 1040; \
        _Pragma("unroll") for (int i = 0; i < 4; ++i) glds16_nt(p_ + i * st_, (unsigned)(uintptr_t)(d_ + i * 8 * 1040)); ++cx.c; } while (0)
#define CONV_TREAD(lag) do { if (cx.r + (lag) < cx.c && cx.r < cx.ns) { const int sl_ = cx.s0 + cx.r; const BigItem cs_ = big_item(a, sl_ >> 2); const int n_ = tid & 255, kh_ = tid >> 8; \
        const int drow_ = (n_ < 128 ? cs_.dA : cs_.dB) + (n_ & 127); const LAS float* sp_ = (const LAS float*)(Cs + (cx.r & 1) * CONV_SLOT) + (16 * kh_) * 260 + n_; u32x4 o_; \
        _Pragma("unroll") for (int h = 0; h < 4; ++h) { const f32x4 x_ = {sp_[(4 * h) * 260], sp_[(4 * h + 1) * 260], sp_[(4 * h + 2) * 260], sp_[(4 * h + 3) * 260]}; o_[h] = pack4_fp8(x_ * 64.0f); } \
        *(u32x4*)(cs_.WT8 + (size_t)drow_ * 1024 + cs_.k0 + 32 * (sl_ & 3) + 16 * kh_) = o_; ++cx.r; } } while (0)
__device__ __forceinline__ void expert_weight_share(const KA& a, LAS unsigned char* lds) {
    int tid = threadIdx.x; asm volatile("" : "+v"(tid));
    const int lane = tid & 63, w = __builtin_amdgcn_readfirstlane(tid >> 6);
    constexpr int NIT = 32 * 96, HB = 64 * 1040;
    const int G = (int)gridDim.x, bx = (int)blockIdx.x;
    const int NHF = CONV_IN_ITEMS + bx < NIT ? 2 * ((NIT - CONV_IN_ITEMS - bx + G - 1) / G) : 0;
#define DMA_ISSUE(h_) do { const BigItem b_ = big_item(a, CONV_IN_ITEMS + bx + ((h_) >> 1) * G); const float* src_ = b_.W + (size_t)(b_.k0 + 64 * ((h_) & 1) + w) * b_.N + b_.n0 + 4 * lane; \
        LAS unsigned char* dst_ = lds + ((h_) & 1) * HB + w * 1040; \
        _Pragma("unroll") for (int i = 0; i < 8; ++i) __builtin_amdgcn_global_load_lds((const unsigned*)(src_ + (size_t)(8 * i) * b_.N), (LAS unsigned*)(dst_ + i * 8 * 1040), 16, 0, 2); } while (0)
    if (NHF > 0) DMA_ISSUE(0);
#pragma unroll 1
    for (int h = 0; h < NHF; ++h) {
        if (h + 1 < NHF) { DMA_ISSUE(h + 1); asm volatile("s_waitcnt vmcnt(8)" ::: "memory"); } else asm volatile("s_waitcnt vmcnt(0)" ::: "memory");
        __builtin_amdgcn_s_barrier();
        { const BigItem b = big_item(a, CONV_IN_ITEMS + bx + (h >> 1) * G); const int n = tid & 255, kh = tid >> 8; const int drow = (n < 128 ? b.dA : b.dB) + (n & 127);
          const LAS float* sp = (const LAS float*)(lds + (h & 1) * HB) + (32 * kh) * 260 + n;
          unsigned char* dst = b.WT8 + (size_t)drow * 1024 + b.k0 + 64 * (h & 1) + 32 * kh;
#pragma unroll
          for (int q = 0; q < 2; ++q) { u32x4 o;
#pragma unroll
              for (int hh = 0; hh < 4; ++hh) { const LAS float* s4 = sp + (16 * q + 4 * hh) * 260; const f32x4 x = {s4[0], s4[260], s4[520], s4[780]}; o[hh] = pack4_fp8(x * 64.0f); }
              *(u32x4*)(dst + 16 * q) = o; } }
        asm volatile("s_waitcnt lgkmcnt(0)" ::: "memory");
        __builtin_amdgcn_s_barrier();
    }
#undef DMA_ISSUE
    __syncthreads();
}
__device__ __forceinline__ int map_in(int n0) {
    if (n0 < 416) return n0;
    if (n0 < 928) { const int j = n0 - 416; return 512 + (j >> 7) * 256 + (j & 127); }
    if (n0 < 1440) { const int j = n0 - 928; return 512 + (j >> 7) * 256 + 128 + (j & 127); }
    if (n0 < 1952) return 1536 + (n0 - 1440);
    if (n0 < 2976) return 2048 + (n0 - 1952);
    return 3072 + (n0 - 2976);
}
__device__ __forceinline__ void phase0(const KA& a, LAS unsigned char* lds, int gw, int NGW, int wave, int lane) {
    unsigned char* ws = a.ws;
    LAS float* scr = (LAS float*)(lds + wave * 16384);
    constexpr int I0 = 16 * 125, I1 = 4 * 24, I2 = 2 * 32, I3 = 8 * 32, I4 = 8 * 32, I5 = 16 * 32, I6 = MOE_FP8 ? 0 : 32 * 16 * 64, I7 = MOE_FP8 ? 0 : 32 * 16 * 32;
    constexpr int NIT = I0 + I1 + I2 + I3 + I4 + I5 + I6 + I7;
    for (int it = gw; it < NIT; it += NGW) {
        int r = it;
        if (r < I0) { const int kb = r / 125, nb = r % 125; p0_item<false>((const float*)a.in(I_WIN), INW, 64 * kb, 32 * nb, (bf16_t*)(ws + WS_WIN), 1024, map_in(32 * nb), nullptr, scr, lane); continue; } r -= I0;
        if (r < I1) { const int kb = r / 24, nb = r % 24; p0_item<false>((const float*)a.in(I_WUQ), 768, 64 * kb, 32 * nb, (bf16_t*)(ws + WS_WUP), 256, 32 * nb, (const float*)a.in(I_GQ), scr, lane); continue; } r -= I1;
        if (r < I2) { const int kb = r / 32, nb = r % 32, n0 = 32 * nb, h = n0 >> 7, j = n0 & 127; const int drow = 768 + (j < 64 ? 64 * h + j : 512 + 64 * h + (j - 64));
            p0_item<false>((const float*)a.in(I_WUKV), 1024, 64 * kb, n0, (bf16_t*)(ws + WS_WUP), 256, drow, (const float*)a.in(I_GKV), scr, lane); continue; } r -= I2;
        if (r < I3) { const int kb = r / 32, nb = r % 32; p0_item<false>((const float*)a.in(I_WA), 1024, 64 * kb, 32 * nb, (bf16_t*)(ws + WS_WA), 1024, 32 * nb, nullptr, scr, lane); continue; } r -= I3;
        if (r < I4) { const int kb = r / 32, nb = r % 32; p0_item<false>((const float*)a.in(I_WC), 1024, 64 * kb, 32 * nb, (bf16_t*)(ws + WS_WA) + 512, 1024, 32 * nb, nullptr, scr, lane); continue; } r -= I4;
        if (r < I5) { const int kb = r / 32, nb = r % 32; p0_item<false>((const float*)a.in(I_WO), 1024, 64 * kb, 32 * nb, (bf16_t*)(ws + WS_WO), 1024, 32 * nb, nullptr, scr, lane); continue; } r -= I5;
        if (r < I6) { const int e = r / 1024, q = r % 1024, kb = q / 64, nb = q % 64, n0 = 32 * nb; const int drow = n0 < 1024 ? (n0 >> 7) * 256 + (n0 & 127) : ((n0 - 1024) >> 7) * 256 + 128 + ((n0 - 1024) & 127);
            p0_item<MOE_FP8 != 0>((const float*)a.in(I_WGU) + (size_t)e * 1024 * 2048, 2048, 64 * kb, n0, (bf16_t*)(ws + WS_WGU + (size_t)e * 2048 * 1024 * ME), 1024, drow, nullptr, scr, lane); continue; } r -= I6;
        if (I7) { const int e = r / 512, q = r % 512, kb = q / 32, nb = q % 32;
            p0_item<MOE_FP8 != 0>((const float*)a.in(I_WD) + (size_t)e * 1024 * 1024, 1024, 64 * kb, 32 * nb, (bf16_t*)(ws + WS_WD + (size_t)e * 1024 * 1024 * ME), 1024, 32 * nb, nullptr, scr, lane); }
    }
    { const int gt = gw * 64 + lane, NGT = NGW * 64; const u32x4 z = {0u, 0u, 0u, 0u};
        for (int i = gt; i < 96 * 128; i += NGT) *(u32x4*)((bf16_t*)(ws + WS_WIN) + (size_t)416 * 1024 + (size_t)i * 8) = z;
        for (int i = gt; i < 1024 * 16; i += NGT) { const int row = 768 + (i >> 4), ch = i & 15; *(u32x4*)((bf16_t*)(ws + WS_WUP) + (size_t)row * 256 + 128 + ch * 8) = z; } }
    { const float* cc = (const float*)a.in(I_C); const float* wa = (const float*)a.in(I_WADA); float* adap = (float*)(ws + WS_ADAP);
        for (int t = gw; t < 96 * 16; t += NGW) { const int cg = t % 96, ks = t / 96;
            float sc[4], acc[4] = {0.f, 0.f, 0.f, 0.f};
#pragma unroll
            for (int b = 0; b < 4; ++b) { const float v = cc[b * 1024 + ks * 64 + lane]; sc[b] = v / (1.0f + expf(-v)); }
#pragma unroll 8
            for (int kk = 0; kk < 64; ++kk) { const float w = wa[(size_t)(ks * 64 + kk) * 6144 + cg * 64 + lane];
#pragma unroll
                for (int b = 0; b < 4; ++b) acc[b] = fmaf(__shfl(sc[b], kk), w, acc[b]); }
#pragma unroll
            for (int b = 0; b < 4; ++b) adap[(size_t)(ks * 4 + b) * 6144 + cg * 64 + lane] = acc[b]; } }
}

__device__ __forceinline__ void phase1(const KA& a, LAS unsigned char* lds, int tid, int wave, int lane) {
    unsigned char* ws = a.ws; const float* adap = (const float*)(ws + WS_ADAP); const float* bada = (const float*)a.in(I_BADA); float* ada = (float*)(ws + WS_ADA);
    for (int j = blockIdx.x * NTHREADS + tid; j < 4 * 6144; j += gridDim.x * NTHREADS) { const int b = j / 6144, n = j % 6144; float pv[16];
#pragma unroll
        for (int ks = 0; ks < 16; ++ks) pv[ks] = adap[(size_t)(ks * 4 + b) * 6144 + n];
        float s = bada[n];
#pragma unroll
        for (int ks = 0; ks < 16; ++ks) s += pv[ks];
        ada[j] = s; }
    LAS float* al = (LAS float*)lds; LAS float* shl = al + 1024;
    const float* gmix = (const float*)a.in(I_GMIX); const float* X = (const float*)a.in(I_X); bf16_t* H = (bf16_t*)(ws + WS_H);
    const int* pos = (const int*)a.in(I_POS); float* CSt = (float*)(ws + WS_CS); float* SNt = (float*)(ws + WS_SN);
    for (int rb = blockIdx.x; rb < T / 64; rb += gridDim.x) {
        const int b = rb / 64;
        __syncthreads();
        { static_assert(NTHREADS == 512, "two modulation columns per thread");
          float ph[2][16], pc[2][16], bh[2], bc[2], gm[2];
#pragma unroll
          for (int q = 0; q < 2; ++q) { const int n = tid + 512 * q; bh[q] = bada[n]; bc[q] = bada[1024 + n]; gm[q] = gmix[n];
#pragma unroll
              for (int ks = 0; ks < 16; ++ks) { ph[q][ks] = adap[(size_t)(ks * 4 + b) * 6144 + n]; pc[q][ks] = adap[(size_t)(ks * 4 + b) * 6144 + 1024 + n]; } }
#pragma unroll
          for (int q = 0; q < 2; ++q) { const int n = tid + 512 * q; float sh = bh[q], sc = bc[q];
#pragma unroll
              for (int ks = 0; ks < 16; ++ks) { sh += ph[q][ks]; sc += pc[q][ks]; }
              al[n] = gm[q] * (1.0f + sc); shl[n] = sh; } }
        __syncthreads();
        for (int r = wave; r < 64; r += NWAVES) { const size_t row = (size_t)rb * 64 + r;
            f32x4 v[4]; float s = 0.f;
#pragma unroll
            for (int j = 0; j < 4; ++j) { v[j] = *(const f32x4*)(X + row * 1024 + 4 * lane + 256 * j); s += (v[j][0] * v[j][0] + v[j][1] * v[j][1]) + (v[j][2] * v[j][2] + v[j][3] * v[j][3]); }
            const float rstd = 1.0f / sqrtf(wave_sum(s) * (1.0f / 1024.0f) + RMS_EPS);
#pragma unroll
            for (int j = 0; j < 4; ++j) { const int c0 = 4 * lane + 256 * j; const f32x4 av = *(const LAS f32x4*)(al + c0), sv = *(const LAS f32x4*)(shl + c0);
                *(u32x2*)(H + row * 1024 + c0) = pack4(v[j] * rstd * av + sv); }
            if (lane < 16) { const float ang = (float)pos[row] * exp2f(-(float)lane * (13.287712379549449f / 16.0f)); float sn, cs; sincosf(ang, &sn, &cs);
                CSt[row * 16 + lane] = cs; SNt[row * 16 + lane] = sn; }
        }
    }
}

__device__ __forceinline__ void conv_rows(const KA& a, int blk0, int blk1, int first, int step, int lane) {
    unsigned char* ws = a.ws; const bf16_t* VC = (const bf16_t*)(ws + WS_VC); const bf16_t* BG = (const bf16_t*)(ws + WS_BG); bf16_t* BZ = (bf16_t*)(ws + WS_OB) + 512;
    const float* cw = (const float*)a.in(I_CONVW);
    float w0[8], w1[8], w2[8];
#pragma unroll
    for (int t = 0; t < 8; ++t) { w0[t] = cw[8 * lane + t]; w1[t] = cw[512 + 8 * lane + t]; w2[t] = cw[1024 + 8 * lane + t]; }
    for (int blk = blk0 + first; blk < blk1; blk += step) { const int row0 = 4 * blk;
        u32x4 bgw[4], vcw[6];
#pragma unroll
        for (int q = 0; q < 4; ++q) bgw[q] = *(const u32x4*)(BG + (size_t)(row0 + q) * 512 + 8 * lane);
#pragma unroll
        for (int q = 0; q < 6; ++q) { const int r = row0 - 2 + q; vcw[q] = r >= 0 ? *(const u32x4*)(VC + (size_t)r * 512 + 8 * lane) : (u32x4){0u, 0u, 0u, 0u}; }
#pragma unroll
        for (int q = 0; q < 4; ++q) { const int row = row0 + q, s = row & (SEQ - 1);
            float v0[8], v1[8], v2[8], bg[8];
            unpack8(vcw[q + 2], v0); unpack8(bgw[q], bg); unpack8(vcw[q + 1], v1); unpack8(vcw[q], v2);
            if (s < 1) {
#pragma unroll
                for (int t = 0; t < 8; ++t) v1[t] = 0.f; }
            if (s < 2) {
#pragma unroll
                for (int t = 0; t < 8; ++t) v2[t] = 0.f; }
            f32x4 r0, r1;
#pragma unroll
            for (int t = 0; t < 4; ++t) { r0[t] = bg[t] * (w0[t] * v2[t] + w1[t] * v1[t] + w2[t] * v0[t]); r1[t] = bg[4 + t] * (w0[4 + t] * v2[4 + t] + w1[4 + t] * v1[4 + t] + w2[4 + t] * v0[4 + t]); }
            *(u32x4*)(BZ + (size_t)row * 1024 + 8 * lane) = pack8(r0, r1); }
    }
}

__device__ __forceinline__ void phase5_ref(const KA& a, int gw, int NGW, int lane) {
    unsigned char* ws = a.ws; const bf16_t* Q = (const bf16_t*)(ws + WS_Q); const bf16_t* K = (const bf16_t*)(ws + WS_K); const bf16_t* V = (const bf16_t*)(ws + WS_V); bf16_t* O = (bf16_t*)(ws + WS_OB);
    int vz; asm volatile("v_mov_b32 %0, 0" : "=v"(vz));
    for (int uu = gw; uu < 4 * NH * 64; uu += NGW) {
        const int b = uu >> 9, h = (uu >> 6) & 7, cq = 63 - (uu & 63);
        const size_t row = (size_t)b * SEQ + cq * 64 + lane;
        float q[96];
#pragma unroll
        for (int c = 0; c < 12; ++c) unpack8(*(const u32x4*)(Q + row * 768 + h * 96 + 8 * c), q + 8 * c);
        float m = -1e30f, l = 0.f, o[64];
#pragma unroll
        for (int d = 0; d < 64; ++d) o[d] = 0.f;
        const int nk = (cq + 1) * 64;
        for (int key = 0; key < nk; ++key) {
            const size_t kr = (size_t)b * SEQ + key + vz;
            float s = 0.f;
#pragma unroll
            for (int c = 0; c < 12; ++c) { float kf[8]; unpack8(*(const u32x4*)(K + kr * 1024 + h * 128 + 8 * c), kf);
#pragma unroll
                for (int t = 0; t < 8; ++t) s = fmaf(q[8 * c + t], kf[t], s); }
            s *= ATT_SCALE;
            const float mn = fmaxf(m, s), al = __expf(m - mn), p = __expf(s - mn);
            l = l * al + p; m = mn;
#pragma unroll
            for (int c = 0; c < 8; ++c) { float vf[8]; unpack8(*(const u32x4*)(V + kr * 512 + h * 64 + 8 * c), vf);
#pragma unroll
                for (int t = 0; t < 8; ++t) o[8 * c + t] = fmaf(o[8 * c + t], al, p * vf[t]); }
        }
        const float rl = 1.0f / l;
#pragma unroll
        for (int c = 0; c < 8; ++c) { f32x4 r0, r1;
#pragma unroll
            for (int t = 0; t < 4; ++t) { r0[t] = o[8 * c + t] * rl; r1[t] = o[8 * c + 4 + t] * rl; }
            *(u32x4*)(O + row * 1024 + h * 64 + 8 * c) = pack8(r0, r1); }
    }
}


namespace at {
constexpr int NW = 8, QBLK = 32, KVBLK = 64, LDQ = 768, LDK = 1024, LDV = 512, LDO = 1024;
constexpr int SHM_V = 8192, SHM_K = 16384;
constexpr int L_V = 0, L_K = 2 * SHM_V, L_WS = L_K + 2 * SHM_K, L_OST = L_WS + NW * 256, L_END = L_OST + NW * 4096;
static_assert(L_END + 2 * 32 * 1040 <= LDS_MISC, "attention LDS + conversion slots");
constexpr float THR = 8.f;
typedef short s16x4 __attribute__((ext_vector_type(4)));
#define KSWZ(row, colB) ((row) * 256 + ((colB) ^ (((row) & 7) << 4)))
#define SBAR() __builtin_amdgcn_sched_barrier(0)
__device__ __forceinline__ int crow(int r, int hi) { return (r & 3) + 8 * (r >> 2) + 4 * hi; }
constexpr float THRL = 11.5f;
__device__ __forceinline__ void partialSM(f32x16& p0, f32x16& p1, float& mhat, float& negm, float& alpha, bool first) {
    float pmax = p0[0];
#pragma unroll
    for (int r = 1; r < 16; ++r) pmax = fmaxf(pmax, p0[r]);
#pragma unroll
    for (int r = 0; r < 16; ++r) pmax = fmaxf(pmax, p1[r]);
    { auto rr = __builtin_amdgcn_permlane32_swap(__float_as_uint(pmax), __float_as_uint(pmax), false, false);
      pmax = fmaxf(__uint_as_float(rr[0]), __uint_as_float(rr[1])); }
    alpha = 1.f;
    if (first || __any(pmax > THRL)) {
        const float dl = first ? pmax : fmaxf(pmax, 0.f);
        mhat += dl;
#pragma unroll
        for (int r = 0; r < 16; ++r) { p0[r] -= dl; p1[r] -= dl; }
        negm = -mhat;
        if (!first) alpha = __builtin_amdgcn_exp2f(-dl);
    }
#pragma unroll
    for (int r = 0; r < 16; ++r) p0[r] = __builtin_amdgcn_exp2f(p0[r]);
}
__device__ __forceinline__ void finishSM(f32x16& p0, f32x16& p1, float alpha, float& l_reg, bf16x8& pa0, bf16x8& pa1, bf16x8& pa2, bf16x8& pa3) {
#pragma unroll
    for (int r = 0; r < 16; ++r) p1[r] = __builtin_amdgcn_exp2f(p1[r]);
    float ps = 0;
#pragma unroll
    for (int r = 0; r < 16; ++r) ps += p0[r];
#pragma unroll
    for (int r = 0; r < 16; ++r) ps += p1[r];
    { auto rr = __builtin_amdgcn_permlane32_swap(__float_as_uint(ps), __float_as_uint(ps), false, false);
      ps = __uint_as_float(rr[0]) + __uint_as_float(rr[1]); }
    l_reg = l_reg * alpha + ps;
#define PK4(P, BASE, OUT) do { unsigned a0 = cvt_pk_bf16(P[BASE + 0], P[BASE + 1]), a1 = cvt_pk_bf16(P[BASE + 2], P[BASE + 3]);   \
    unsigned b0 = cvt_pk_bf16(P[BASE + 4], P[BASE + 5]), b1 = cvt_pk_bf16(P[BASE + 6], P[BASE + 7]);                              \
    auto r0 = __builtin_amdgcn_permlane32_swap(a0, b0, false, false); auto r1 = __builtin_amdgcn_permlane32_swap(a1, b1, false, false); \
    u32x4 w = {r0[0], r1[0], r0[1], r1[1]}; OUT = __builtin_bit_cast(bf16x8, w); } while (0)
    PK4(p0, 0, pa0); PK4(p0, 8, pa1); PK4(p1, 0, pa2); PK4(p1, 8, pa3);
#undef PK4
}
__device__ __forceinline__ void qkt(f32x16& p0, f32x16& p1, const LAS unsigned char* Ks, const bf16x8* qr, float negm_s, int r32, int hi) {
    asm volatile("" : "+v"(negm_s));
    f32x16 negm;
#pragma unroll
    for (int r = 0; r < 16; ++r) negm[r] = negm_s;
    int qb0_ = (int)(unsigned)(uintptr_t)(Ks + KSWZ(r32, hi * 16)), qb1_ = (int)(unsigned)(uintptr_t)(Ks + KSWZ(32 + r32, hi * 16)); asm volatile("" : "+v"(qb0_), "+v"(qb1_));
#define QK_RD(dst, base_, d0_) asm volatile("ds_read_b128 %0, %1" : "=v"(dst) : "v"((base_) ^ ((d0_) * 32)) : "memory")
#define QK_WAIT(n, x, y) asm volatile("s_waitcnt lgkmcnt(" #n ")" : "+v"(x), "+v"(y) :: "memory")
    bf16x8 f0, f1, f2, f3, f4, f5, f6, f7, f8, f9, f10, f11;
    QK_RD(f0, qb0_, 0); QK_RD(f1, qb1_, 0); QK_RD(f2, qb0_, 1); QK_RD(f3, qb1_, 1);
    QK_WAIT(2, f0, f1); p0 = __builtin_amdgcn_mfma_f32_32x32x16_bf16(f0, qr[0], negm, 0, 0, 0); p1 = __builtin_amdgcn_mfma_f32_32x32x16_bf16(f1, qr[0], negm, 0, 0, 0);
    QK_RD(f4, qb0_, 2); QK_RD(f5, qb1_, 2);
    QK_WAIT(2, f2, f3); p0 = __builtin_amdgcn_mfma_f32_32x32x16_bf16(f2, qr[1], p0, 0, 0, 0); p1 = __builtin_amdgcn_mfma_f32_32x32x16_bf16(f3, qr[1], p1, 0, 0, 0);
    QK_RD(f6, qb0_, 3); QK_RD(f7, qb1_, 3);
    QK_WAIT(2, f4, f5); p0 = __builtin_amdgcn_mfma_f32_32x32x16_bf16(f4, qr[2], p0, 0, 0, 0); p1 = __builtin_amdgcn_mfma_f32_32x32x16_bf16(f5, qr[2], p1, 0, 0, 0);
    QK_RD(f8, qb0_, 4); QK_RD(f9, qb1_, 4);
    QK_WAIT(2, f6, f7); p0 = __builtin_amdgcn_mfma_f32_32x32x16_bf16(f6, qr[3], p0, 0, 0, 0); p1 = __builtin_amdgcn_mfma_f32_32x32x16_bf16(f7, qr[3], p1, 0, 0, 0);
    QK_RD(f10, qb0_, 5); QK_RD(f11, qb1_, 5);
    QK_WAIT(2, f8, f9); p0 = __builtin_amdgcn_mfma_f32_32x32x16_bf16(f8, qr[4], p0, 0, 0, 0); p1 = __builtin_amdgcn_mfma_f32_32x32x16_bf16(f9, qr[4], p1, 0, 0, 0);
    QK_WAIT(0, f10, f11); p0 = __builtin_amdgcn_mfma_f32_32x32x16_bf16(f10, qr[5], p0, 0, 0, 0); p1 = __builtin_amdgcn_mfma_f32_32x32x16_bf16(f11, qr[5], p1, 0, 0, 0);
#undef QK_RD
#undef QK_WAIT
}
__device__ __forceinline__ int v_st(int k, int c) { const int kk = (k & ~0xC) | ((k & 4) << 1) | ((k & 8) >> 1); return ((kk >> 3) * 2 + (c >> 5)) * 512 + ((kk & 7) * 32 + (c & 31)) * 2; }
__device__ __forceinline__ int v_rd_base(int lane) { return ((lane & 3) << 3) | (((lane >> 2) & 3) << 6) | (((lane >> 4) & 1) << 5) | (((lane >> 5) & 1) << 8); }
constexpr int v_rd_off(int d0, int ks, int half) { return d0 * 512 + ks * 2048 + half * 1024; }
template <int OFF> __device__ __forceinline__ s16x4 tr_read(int vb) { s16x4 r; asm volatile("ds_read_b64_tr_b16 %0, %1 offset:%2" : "=&v"(r) : "v"(vb), "i"(OFF) : "memory"); return r; }
template <int D0> __device__ __forceinline__ void pv_one(f32x16& od, int vb, bf16x8 pa0, bf16x8 pa1, bf16x8 pa2, bf16x8 pa3) {
    const s16x4 l0 = tr_read<v_rd_off(D0, 0, 0)>(vb), h0 = tr_read<v_rd_off(D0, 0, 1)>(vb), l1 = tr_read<v_rd_off(D0, 1, 0)>(vb), h1 = tr_read<v_rd_off(D0, 1, 1)>(vb);
    const s16x4 l2 = tr_read<v_rd_off(D0, 2, 0)>(vb), h2 = tr_read<v_rd_off(D0, 2, 1)>(vb), l3 = tr_read<v_rd_off(D0, 3, 0)>(vb), h3 = tr_read<v_rd_off(D0, 3, 1)>(vb);
    asm volatile("s_waitcnt lgkmcnt(0)" ::: "memory"); SBAR();
#define PK(L, H) (bf16x8){L[0], L[1], L[2], L[3], H[0], H[1], H[2], H[3]}
    od = __builtin_amdgcn_mfma_f32_32x32x16_bf16(pa0, PK(l0, h0), od, 0, 0, 0);
    od = __builtin_amdgcn_mfma_f32_32x32x16_bf16(pa1, PK(l1, h1), od, 0, 0, 0);
    od = __builtin_amdgcn_mfma_f32_32x32x16_bf16(pa2, PK(l2, h2), od, 0, 0, 0);
    od = __builtin_amdgcn_mfma_f32_32x32x16_bf16(pa3, PK(l3, h3), od, 0, 0, 0);
#undef PK
}
__device__ __forceinline__ void pv_d0(f32x16* o, int vb, bf16x8 pa0, bf16x8 pa1, bf16x8 pa2, bf16x8 pa3) { pv_one<0>(o[0], vb, pa0, pa1, pa2, pa3); pv_one<1>(o[1], vb, pa0, pa1, pa2, pa3); }

__device__ __forceinline__ void attn_unit(int b, int h, int qb, const bf16_t* __restrict__ Q, const bf16_t* __restrict__ K, const bf16_t* __restrict__ V, bf16_t* __restrict__ O, LAS unsigned char* lds, const KA& a, ConvCtx& cx) {
    int tid_ = threadIdx.x; asm volatile("" : "+v"(tid_));
    const int tid = tid_, wid = __builtin_amdgcn_readfirstlane(tid >> 6), lane = tid & 63, r32 = lane & 31, hi = lane >> 5;
    LAS unsigned char* V_lds = lds + L_V; LAS unsigned char* K_lds = lds + L_K;
    LAS float* wsf = (LAS float*)(lds + L_WS) + wid * 64; LAS float* li_l = wsf; LAS float* al_l = wsf + 32; LAS unsigned char* Cs = lds + L_END;
    const size_t rowbase = (size_t)b * SEQ; const int q0 = qb * 256;
    const bf16_t* Kh = K + rowbase * LDK + h * 128; const bf16_t* Vh = V + rowbase * LDV + h * 64;
    float mhat = 0.f, l_reg = 0; f32x16 o[2] = {}; bf16x8 qr[6]; float negm = 0.f;
    const bf16_t* Qw = Q + (rowbase + q0 + wid * QBLK + r32) * LDQ + h * 96 + hi * 8;
#pragma unroll
    for (int d0 = 0; d0 < 6; ++d0) qr[d0] = *(const bf16x8*)(Qw + d0 * 16);
    const int cw = 4 * qb + (wid >> 1);
    const bool late = wid >= 4;
    const int sr = tid >> 4, sc = (tid & 15) * 8, vk = tid >> 3, vc = (tid & 7) * 8, vst = v_st(vk, vc); const bool kact = sc < 96; const int scl = kact ? sc : 0;
    const int vb0 = (int)(unsigned)(uintptr_t)V_lds + v_rd_base(lane);
    struct { bf16x8 vs, ks0, ks1; } sr_[2];
#define GLD128(dst, ptr) asm volatile("global_load_dwordx4 %0, %1, off" : "=v"(dst) : "v"(ptr) : "memory")
#define SLOAD(i, k0) do { GLD128(sr_[i].vs, Vh + (size_t)((k0) + vk) * LDV + vc); \
    GLD128(sr_[i].ks0, Kh + (size_t)((k0) + sr) * LDK + scl); GLD128(sr_[i].ks1, Kh + (size_t)((k0) + 32 + sr) * LDK + scl); } while (0)
#define SREADY(i, n) asm volatile("s_waitcnt vmcnt(" #n ")" : "+v"(sr_[i].vs), "+v"(sr_[i].ks0), "+v"(sr_[i].ks1) :: "memory")
#define LDS_ST128(addr, v) asm volatile("ds_write_b128 %0, %1" :: "v"(addr), "v"(v) : "memory")
#define SWRITE(bb, i) do { LDS_ST128((int)(unsigned)(uintptr_t)(V_lds + (bb) * SHM_V + vst), sr_[i].vs); const int kc = sc * 2; \
    if (kact) { LDS_ST128((int)(unsigned)(uintptr_t)(K_lds + (bb) * SHM_K + KSWZ(sr, kc)), sr_[i].ks0); LDS_ST128((int)(unsigned)(uintptr_t)(K_lds + (bb) * SHM_K + KSWZ(32 + sr, kc)), sr_[i].ks1); } } while (0)
#define SWAIT() asm volatile("s_waitcnt vmcnt(0)" ::: "memory")
#define WGBAR() do { asm volatile("s_waitcnt lgkmcnt(0)" ::: "memory"); __builtin_amdgcn_s_barrier(); asm volatile("" ::: "memory"); } while (0)
#define RESC(a) do { if (__any((a) < 1.f)) { if (hi == 0) asm volatile("ds_write_b32 %0, %1" :: "v"((int)(unsigned)(uintptr_t)(al_l + r32)), "v"(a) : "memory"); asm volatile("s_waitcnt lgkmcnt(0)" ::: "memory"); \
    _Pragma("unroll") for (int d = 0; d < 2; ++d) _Pragma("unroll") for (int r = 0; r < 16; ++r) o[d][r] *= al_l[crow(r, hi)]; } } while (0)
    f32x16 pA0, pA1, pB0, pB1; float alA = 1.f, alB = 1.f; bf16x8 pa0, pa1, pa2, pa3; const int NT = 4 * qb + 4;
    SLOAD(0, 0); SREADY(0, 0); SWRITE(0, 0); __syncthreads();
    SLOAD(1, KVBLK); SLOAD(0, 2 * KVBLK);
    qkt(pA0, pA1, K_lds, qr, negm, r32, hi); partialSM(pA0, pA1, mhat, negm, alA, true);
    SREADY(1, 3); SWRITE(1, 1); __syncthreads();
    for (int j = 1; j + 1 < NT; j += 2) {
        const bool v0 = j - 1 <= cw, v1 = j <= cw, v2 = j + 1 <= cw;
        const int t2 = j + 2 < NT ? j + 2 : NT - 1, t3 = j + 3 < NT ? j + 3 : NT - 1;
#define SYNC_EVEN(do_resc) do { WGBAR(); SREADY(0, 7); SWRITE(0, 0);        \
        if (do_resc) RESC(alB); asm volatile("s_waitcnt vmcnt(10)" ::: "memory");        \
        WGBAR(); } while (0)
#define SYNC_ODD(do_resc) do { WGBAR(); SREADY(1, 7); SWRITE(1, 1); CONV_TREAD(1);     \
        if (do_resc) RESC(alA); WGBAR(); } while (0)
        SBAR(); if (v1) qkt(pB0, pB1, K_lds + SHM_K, qr, negm, r32, hi);
        if (v0) finishSM(pA0, pA1, alA, l_reg, pa0, pa1, pa2, pa3); SBAR();
        SLOAD(1, t2 * KVBLK); CONV_DMA(); SBAR();
        if (v0) pv_d0(o, vb0, pa0, pa1, pa2, pa3); SBAR();
        if (late) SYNC_EVEN(false);
        alB = 1.f; if (v1) partialSM(pB0, pB1, mhat, negm, alB, false);
        if (late) RESC(alB); else SYNC_EVEN(true);
        SBAR(); if (v2) qkt(pA0, pA1, K_lds, qr, negm, r32, hi);
        if (v1) finishSM(pB0, pB1, alB, l_reg, pa0, pa1, pa2, pa3); SBAR();
        SLOAD(0, t3 * KVBLK); SBAR();
        if (v1) pv_d0(o, vb0 + SHM_V, pa0, pa1, pa2, pa3); SBAR();
        if (late) SYNC_ODD(false);
        alA = 1.f; if (v2) partialSM(pA0, pA1, mhat, negm, alA, false);
        if (late) RESC(alA); else SYNC_ODD(true);
    }
#undef SYNC_EVEN
#undef SYNC_ODD
    { const bool v0 = NT - 2 <= cw, v1 = NT - 1 <= cw;
    SBAR(); if (v1) qkt(pB0, pB1, K_lds + SHM_K, qr, negm, r32, hi);
    if (v0) finishSM(pA0, pA1, alA, l_reg, pa0, pa1, pa2, pa3); SBAR();
    if (v0) pv_d0(o, vb0, pa0, pa1, pa2, pa3); alB = 1.f; if (v1) partialSM(pB0, pB1, mhat, negm, alB, false);
    __syncthreads(); RESC(alB);
    if (v1) { finishSM(pB0, pB1, alB, l_reg, pa0, pa1, pa2, pa3); SBAR();
        pv_d0(o, vb0 + SHM_V, pa0, pa1, pa2, pa3); } }
    SREADY(0, 0);
    if (hi == 0) li_l[r32] = l_reg; asm volatile("s_waitcnt lgkmcnt(0)" ::: "memory");
    float rli[16];
#pragma unroll
    for (int r = 0; r < 16; ++r) rli[r] = __builtin_amdgcn_rcpf(li_l[crow(r, hi)]);
    LAS bf16_t* stg = (LAS bf16_t*)(lds + L_OST) + wid * 2048;
#pragma unroll
    for (int r = 0; r < 16; ++r) { const int orow = crow(r, hi);
#pragma unroll
        for (int d0 = 0; d0 < 2; ++d0) stg[orow * 64 + d0 * 32 + r32] = (bf16_t)(cvt_pk_bf16(o[d0][r] * rli[r], 0.f) & 0xffffu); }
    asm volatile("s_waitcnt lgkmcnt(0)" ::: "memory");
    bf16_t* Ow = O + (rowbase + q0 + wid * QBLK) * LDO + h * 64;
#pragma unroll
    for (int i = 0; i < 4; ++i) { const int row = i * 8 + (lane >> 3), ch = lane & 7; const u32x4 v = *(const LAS u32x4*)(stg + row * 64 + ch * 8); *(u32x4*)(Ow + (size_t)row * LDO + ch * 8) = v; }
    asm volatile("s_waitcnt lgkmcnt(0)" ::: "memory"); __syncthreads();
#undef SLOAD
#undef GLD128
#undef SREADY
#undef SWRITE
#undef LDS_ST128
#undef SWAIT
#undef WGBAR
#undef RESC
}
#undef KSWZ
#undef SBAR
}
__device__ __forceinline__ void phase5_fast(const KA& a, LAS unsigned char* lds) {
    unsigned char* ws = a.ws; const bf16_t* Q = (const bf16_t*)(ws + WS_Q); const bf16_t* K = (const bf16_t*)(ws + WS_K); const bf16_t* V = (const bf16_t*)(ws + WS_V); bf16_t* O = (bf16_t*)(ws + WS_OB);
    const int G = gridDim.x, bx = blockIdx.x; const int vcu = (G % 8 == 0) ? (bx % 8) * (G / 8) + bx / 8 : bx;
    ConvCtx cx; cx.c = 0; cx.r = 0; { const int spw = (CONV_SLICES + G - 1) / G; cx.s0 = bx * spw; const int left = CONV_SLICES - cx.s0; cx.ns = MOE_FP8 ? (left < 0 ? 0 : (left < spw ? left : spw)) : 0; }
    int tid = threadIdx.x; asm volatile("" : "+v"(tid)); const int wid = __builtin_amdgcn_readfirstlane(tid >> 6), lane = tid & 63; LAS unsigned char* Cs = lds + at::L_END;
#define CONV_DRAIN() do { asm volatile("s_waitcnt vmcnt(0)" ::: "memory"); __syncthreads(); CONV_TREAD(0); CONV_TREAD(0); __syncthreads(); } while (0)
    for (int it = vcu; it < 4 * NH * 8; it += G) { const int bh = it >> 3, s8 = it & 7;
        const bool longfirst = (s8 & 2) != 0;
        const int qfirst = longfirst ? 15 - s8 : s8, qsecond = longfirst ? s8 : 15 - s8;
        at::attn_unit(bh >> 3, bh & 7, qfirst, Q, K, V, O, lds, a, cx);
        if (MOE_FP8 && it == vcu) { CONV_DRAIN(); expert_weight_share(a, lds); }
        at::attn_unit(bh >> 3, bh & 7, qsecond, Q, K, V, O, lds, a, cx); }
    if (MOE_FP8 && vcu >= 4 * NH * 8) expert_weight_share(a, lds);
    CONV_DRAIN();
#pragma unroll 1
    while (cx.c < cx.ns) { CONV_DMA(); CONV_DRAIN(); }
#undef CONV_DRAIN
}

constexpr int HB_PITCH = 1028;
constexpr int R_AF = 32 * HB_PITCH * 4, R_SHF = R_AF + 4096, R_HIST = R_SHF + 4096;
static_assert(R_HIST + 256 <= LDS_MOE, "router LDS");
__device__ __forceinline__ void phase8(const KA& a, LAS unsigned char* lds, int tid, int wave, int lane) {
    unsigned char* ws = a.ws; const bf16_t* X1 = (const bf16_t*)(ws + WS_X1); const float* ada = (const float*)(ws + WS_ADA); const float* gffn = (const float*)a.in(I_GFFN);
    const float* rw = (const float*)a.in(I_RW); const float* rb = (const float*)a.in(I_RB);
    bf16_t* H2 = (bf16_t*)(ws + WS_H); int* RFLAT = (int*)(ws + WS_RFLAT); float* GW = (float*)(ws + WS_GW); unsigned* cnt = (unsigned*)(ws + WS_CTL) + CW_CNT;
    LAS float* HB = (LAS float*)lds; LAS float* AF = (LAS float*)(lds + R_AF); LAS float* SHF = (LAS float*)(lds + R_SHF);
    LAS float* PART = (LAS float*)lds;
    LAS float* LOG = (LAS float*)(lds + 32768);
    LAS int* HIST = (LAS int*)(lds + R_HIST);
    LAS int* BASE = HIST + 32;
    float rwv[64];
    { const int i = lane & 31, half = lane >> 5, kb = wave * 128;
#pragma unroll
        for (int jj = 0; jj < 16; ++jj)
#pragma unroll
            for (int t = 0; t < 4; ++t) rwv[jj * 4 + t] = rw[(size_t)(kb + 8 * jj + 4 * half + t) * 32 + i]; }
#define P8BAR() do { asm volatile("s_waitcnt lgkmcnt(0)" ::: "memory"); __builtin_amdgcn_s_barrier(); asm volatile("" ::: "memory"); } while (0)
    for (int blk = blockIdx.x; blk < T / 64; blk += gridDim.x) {
        const int b = (blk * 64) >> 12;
        u32x2 xw[4][4];
#pragma unroll
        for (int r = 0; r < 4; ++r)
#pragma unroll
            for (int j = 0; j < 4; ++j) xw[r][j] = *(const u32x2*)(X1 + (size_t)(blk * 64 + wave * 4 + r) * 1024 + 4 * lane + 256 * j);
        P8BAR();
        for (int n = tid; n < 1024; n += NTHREADS) { AF[n] = gffn[n] * (1.0f + ada[b * 6144 + 4096 + n]); SHF[n] = ada[b * 6144 + 3072 + n]; }
        if (tid < 32) HIST[tid] = 0;
        int se[2][2], sl[2][2]; float sw[2][2];
#pragma unroll
        for (int pass = 0; pass < 2; ++pass) {
            const int tok0 = blk * 64 + 32 * pass;
            P8BAR();
            { f32x4 v[4][4]; float ss[4];
#pragma unroll
              for (int r = 0; r < 4; ++r) { float s_ = 0.f;
#pragma unroll
                  for (int j = 0; j < 4; ++j) { v[r][j] = (f32x4){bf_lo(xw[r][j].x), bf_hi(xw[r][j].x), bf_lo(xw[r][j].y), bf_hi(xw[r][j].y)}; s_ += (v[r][j][0] * v[r][j][0] + v[r][j][1] * v[r][j][1]) + (v[r][j][2] * v[r][j][2] + v[r][j][3] * v[r][j][3]); }
                  ss[r] = s_; }
#pragma unroll
              for (int o = 1; o < 64; o <<= 1) {
#pragma unroll
                  for (int r = 0; r < 4; ++r) ss[r] += __shfl_xor(ss[r], o); }
#pragma unroll
              for (int r = 0; r < 4; ++r) { const size_t row = (size_t)tok0 + wave * 4 + r; const float rstd = 1.0f / sqrtf(ss[r] * (1.0f / 1024.0f) + RMS_EPS);
#pragma unroll
                  for (int j = 0; j < 4; ++j) { const int c0 = 4 * lane + 256 * j; const f32x4 h = v[r][j] * rstd * *(const LAS f32x4*)(AF + c0) + *(const LAS f32x4*)(SHF + c0);
                      if (MOE_FP8) *(unsigned*)((unsigned char*)H2 + row * 1024 + c0) = pack4_fp8(h); else *(u32x2*)(H2 + row * 1024 + c0) = pack4(h);
                      *(LAS f32x4*)(HB + (wave * 4 + r) * HB_PITCH + c0) = h; } }
              if (pass == 0) {
#pragma unroll
                  for (int r = 0; r < 4; ++r)
#pragma unroll
                      for (int j = 0; j < 4; ++j) xw[r][j] = *(const u32x2*)(X1 + (size_t)(tok0 + 32 + wave * 4 + r) * 1024 + 4 * lane + 256 * j); } }
            P8BAR();
            f32x16 acc = {};
            { const int i = lane & 31, half = lane >> 5, kb = wave * 128;
#pragma unroll
                for (int jj = 0; jj < 16; ++jj) { const f32x4 a4 = *(const LAS f32x4*)(HB + i * HB_PITCH + kb + 8 * jj + 4 * half);
#pragma unroll
                    for (int t = 0; t < 4; ++t) acc = __builtin_amdgcn_mfma_f32_32x32x2f32(a4[t], rwv[jj * 4 + t], acc, 0, 0, 0); } }
            P8BAR();
            { const int e = lane & 31, half = lane >> 5;
#pragma unroll
                for (int r = 0; r < 16; ++r) { const int tk = (r & 3) + 8 * (r >> 2) + 4 * half; PART[(wave * 32 + tk) * 32 + e] = acc[r]; } }
            P8BAR();
            for (int idx = tid; idx < 1024; idx += NTHREADS) { const int tk = idx >> 5, e = idx & 31; float s_ = rb[e];
#pragma unroll
                for (int w = 0; w < 8; ++w) s_ += PART[(w * 32 + tk) * 32 + e];
                LOG[tk * 33 + e] = s_; }
            P8BAR();
#pragma unroll
            for (int it2 = 0; it2 < 2; ++it2) { const int e = lane & 31, half = lane >> 5, tk = wave * 4 + 2 * it2 + half;
                float v = LOG[tk * 33 + e]; float tv[4]; int te[4];
#pragma unroll
                for (int k = 0; k < 4; ++k) { float m = v;
#pragma unroll
                    for (int o = 1; o < 32; o <<= 1) m = fmaxf(m, __shfl_xor(m, o));
                    const unsigned long long bal = __ballot(v == m); const unsigned hm = (unsigned)(bal >> (32 * half));
                    const int idx = __builtin_ctz(hm); tv[k] = m; te[k] = idx; if (e == idx) v = -INFINITY; }
                float ex[4], sum = 0.f;
#pragma unroll
                for (int k = 0; k < 4; ++k) { ex[k] = expf(tv[k] - tv[0]); sum += ex[k]; }
                const int k = e & 3; const int myE = k == 0 ? te[0] : k == 1 ? te[1] : k == 2 ? te[2] : te[3]; const float myX = k == 0 ? ex[0] : k == 1 ? ex[1] : k == 2 ? ex[2] : ex[3];
                se[pass][it2] = myE; sw[pass][it2] = myX / sum; sl[pass][it2] = 0;
                if (e < 4) sl[pass][it2] = __hip_atomic_fetch_add(&HIST[myE], 1, __ATOMIC_RELAXED, __HIP_MEMORY_SCOPE_WORKGROUP); }
        }
        P8BAR();
        if (tid < 32) { const int h = HIST[tid]; BASE[tid] = h ? (int)__hip_atomic_fetch_add(cnt + 64 * tid, (unsigned)h, __ATOMIC_RELAXED, __HIP_MEMORY_SCOPE_AGENT) : 0; }
        __syncthreads();
        if ((lane & 31) < 4) {
#pragma unroll
            for (int pass = 0; pass < 2; ++pass)
#pragma unroll
                for (int it2 = 0; it2 < 2; ++it2) { const int tk = blk * 64 + 32 * pass + wave * 4 + 2 * it2 + (lane >> 5); const int f = 4 * tk + (lane & 3);
                    const int pos = BASE[se[pass][it2]] + sl[pass][it2]; RFLAT[(size_t)se[pass][it2] * ECAP + pos] = f; GW[f] = sw[pass][it2]; } }
    }
}

__device__ __forceinline__ void moe_setup(const KA& a, LAS unsigned char* lds, int tid, ge::MoeSched& S, int nN, bool gather) {
    unsigned char* ws = a.ws; unsigned* cnt = (unsigned*)(ws + WS_CTL) + CW_CNT; const int* RFLAT = (const int*)(ws + WS_RFLAT);
    LAS int* tb = (LAS int*)(lds + LDS_MOE); LAS int* CNT = tb + 40; LAS unsigned* tab = (LAS unsigned*)(lds + LDS_TAB);
    LAS int* te = (LAS int*)(lds + LDS_MOE + 512);
    if (gather || MK_N_LAUNCHES != 1) {
        __syncthreads();
        if (tid < 64) {
            const int cn = tid < NE ? (int)__hip_atomic_load(cnt + 64 * tid, __ATOMIC_RELAXED, __HIP_MEMORY_SCOPE_AGENT) : 0;
            const int nt_ = (cn + 255) >> 8; int inc = nt_;
#pragma unroll
            for (int o = 1; o < 32; o <<= 1) { const int v = __shfl_up(inc, o); if ((tid & 63) >= o) inc += v; }
            if (tid < NE) { CNT[tid] = cn; tb[tid] = inc - nt_; } if (tid == NE - 1) tb[NE] = inc; }
        __syncthreads();
        for (int t = tid; t < tb[NE]; t += NTHREADS) { int e = 0; while (e < NE - 1 && t >= tb[e + 1]) ++e; te[t] = e; }
        __syncthreads();
    }
    S.tb = tb; S.te = te; S.tab = tab; S.nN = nN; S.ntiles = __builtin_amdgcn_readfirstlane(tb[NE]); S.G = gridDim.x; S.c = blockIdx.x; S.gather = gather;
    if (gather) {
        Unit u; const int wv = tid >> 6, ln = tid & 63;
        for (int ui = wv; ui < TAB_UNITS; ui += NWAVES) if (S.next(ui, u)) {
#pragma unroll
            for (int q = 0; q < 4; ++q) { const int r = ln + 64 * q, rr = u.aux * 256 + r; const int f = rr < CNT[u.e] ? RFLAT[(size_t)u.e * ECAP + rr] : 0; tab[ui * 256 + r] = (unsigned)(f >> 2) * (unsigned)(1024 * ME); } }
        __syncthreads();
    }
}

__device__ __forceinline__ void phase11(const KA& a, LAS unsigned char* lds, int tid, int wave, int lane) {
    unsigned char* ws = a.ws; const bf16_t* X1 = (const bf16_t*)(ws + WS_X1); float* OUT = a.out; const float* ada = (const float*)(ws + WS_ADA); const float* gfin = (const float*)a.in(I_GFIN);
    const unsigned char* Y = (const unsigned char*)(ws + WS_Y); const float* GW = (const float*)(ws + WS_GW);
    LAS float* GF = (LAS float*)lds; LAS float* GN = GF + 1024;
    for (int rb = blockIdx.x; rb < T / 64; rb += gridDim.x) {
        const int b = rb / 64;
        __syncthreads();
        for (int n = tid; n < 1024; n += NTHREADS) { GF[n] = ada[b * 6144 + 5120 + n]; GN[n] = gfin[n]; }
        __syncthreads();
        for (int r = wave; r < 64; r += NWAVES) { const size_t row = (size_t)rb * 64 + r;
            const f32x4 gw4 = *(const f32x4*)(GW + row * 4);
            f32x4 x2[4]; float s = 0.f;
#pragma unroll
            for (int j = 0; j < 4; ++j) { const int c0 = 4 * lane + 256 * j; f32x4 y = {0.f, 0.f, 0.f, 0.f};
#pragma unroll
                for (int k = 0; k < 4; ++k) { f32x4 yk;
                    if (Y_FP8) { const int w = *(const int*)(Y + (row * 4 + k) * 1024 + c0); yk = (f32x4){__builtin_amdgcn_cvt_f32_fp8(w, 0), __builtin_amdgcn_cvt_f32_fp8(w, 1), __builtin_amdgcn_cvt_f32_fp8(w, 2), __builtin_amdgcn_cvt_f32_fp8(w, 3)} * 0.0625f; }
                    else { const u32x2 w = *(const u32x2*)(Y + ((row * 4 + k) * 1024 + c0) * 2); yk = (f32x4){bf_lo(w.x), bf_hi(w.x), bf_lo(w.y), bf_hi(w.y)}; }
                    y += yk * gw4[k]; }
                const u32x2 xw = *(const u32x2*)(X1 + row * 1024 + c0); const f32x4 x1v = {bf_lo(xw.x), bf_hi(xw.x), bf_lo(xw.y), bf_hi(xw.y)};
                x2[j] = x1v + *(const LAS f32x4*)(GF + c0) * y;
                s += (x2[j][0] * x2[j][0] + x2[j][1] * x2[j][1]) + (x2[j][2] * x2[j][2] + x2[j][3] * x2[j][3]); }
            const float rstd = 1.0f / sqrtf(wave_sum(s) * (1.0f / 1024.0f) + RMS_EPS);
#pragma unroll
            for (int j = 0; j < 4; ++j) { const int c0 = 4 * lane + 256 * j; *(f32x4*)(OUT + row * 1024 + c0) = x2[j] * rstd * *(const LAS f32x4*)(GN + c0); }
        }
    }
}

__global__ void __launch_bounds__(NTHREADS, 2) fwd_kernel(Args args) {
    extern __shared__ __attribute__((aligned(16))) unsigned char lds_raw[];
    LAS unsigned char* lds = (LAS unsigned char*)lds_raw;
    const int tid = threadIdx.x, lane = tid & 63, wave = __builtin_amdgcn_readfirstlane(tid >> 6);
    const int G = gridDim.x, gw = blockIdx.x * NWAVES + wave, NGW = G * NWAVES;
    unsigned char* ws = args.ws;
    KA ka; ka.kp = (kptr_t)__builtin_amdgcn_kernarg_segment_ptr(); ka.ws = args.ws; ka.out = args.out;
    volatile LAS unsigned* MISC = (volatile LAS unsigned*)(lds + LDS_MISC);
    if (tid < 32) MISC[tid] = 0u;
    __syncthreads();
    unsigned* ctl = (unsigned*)(ws + WS_CTL);
    XcdBarrier bar; bar.bar = ctl + CW_BAR; bar.x = 0; bar.st = nullptr;
    if (MK_N_LAUNCHES == 1) { bar = xcd_barrier_post(g_bar, MISC + 8);
        if (blockIdx.x == 0 && tid < NE) __hip_atomic_store(ctl + CW_CNT + 64 * tid, 0u, __ATOMIC_RELAXED, __HIP_MEMORY_SCOPE_AGENT); }
    const int lo = args.ph_lo, hi = args.ph_hi;
#ifndef PHASE_MASK
#define PHASE_MASK 0xFFF
#endif
#define IN(k) ((((PHASE_MASK) >> (k)) & 1) && lo <= (k) && (k) < hi)
#ifndef REP_PHASE
#define REP_PHASE -1
#endif
#define SEAM(k) do { if (IN(k) && IN((k) + 1)) xcd_barrier(bar); } while (0)
#define REPS(k) for (int rep_ = 0; rep_ < ((REP_PHASE) == (k) ? 2 : 1); ++rep_, ((REP_PHASE) == (k) && rep_ < 2 && MK_N_LAUNCHES == 1 ? xcd_barrier(bar) : (void)0))

    if (IN(0)) REPS(0) { phase0(ka, lds, gw, NGW, wave, lane); } SEAM(0);
    if (IN(1)) REPS(1) { phase1(ka, lds, tid, wave, lane); } SEAM(1);
    if (IN(2)) REPS(2) {
        ge::Gemm g{(const char*)(ws + WS_H), (const char*)(ws + WS_WIN), 2048, 2048, 2048};
        ge::DenseSched S; S.init(T, NIN, G, blockIdx.x, 2048, 2048);
        EpiInProj E{(bf16_t*)(ws + WS_LAT), (bf16_t*)(ws + WS_VC), (bf16_t*)(ws + WS_BG), (bf16_t*)(ws + WS_SG), (float*)(ws + WS_RSTDQ), (float*)(ws + WS_RSTDKV), (const float*)(ws + WS_CS), (const float*)(ws + WS_SN), (bf16_t*)(ws + WS_K), (LAS float*)(lds + LDS_TAB)};
        run_gemm<FAST_P2 != 0, false, false>(lds, g, S, E);
    } SEAM(2);
    if (MK_N_LAUNCHES == 1 && blockIdx.x == 0 && tid < 16) __hip_atomic_store(&g_bar[XB_XCNT(tid)], 0u, __ATOMIC_RELAXED, __HIP_MEMORY_SCOPE_AGENT);
    if (IN(4)) REPS(4) {
        ge::Gemm g{(const char*)(ws + WS_LAT), (const char*)(ws + WS_WUP), 1024, 512, 512};
        ge::DenseSched S; S.init(T, 1792, G, blockIdx.x, 1024, 512, 3, 512);
        EpiUp E{(bf16_t*)(ws + WS_Q), (bf16_t*)(ws + WS_K), (bf16_t*)(ws + WS_V), (const float*)(ws + WS_RSTDQ), (const float*)(ws + WS_RSTDKV), (const float*)(ws + WS_CS), (const float*)(ws + WS_SN)};
        run_gemm<FAST_P4 != 0, false, false>(lds, g, S, E);
        if (G == 256) { const int c = blockIdx.x; const int b0 = c < 192 ? 10 * c : 1920 + 34 * (c - 192), b1 = b0 + (c < 192 ? 10 : 34); conv_rows(ka, b0, b1, wave, NWAVES, lane); }
        else conv_rows(ka, 0, T / 4, gw, NGW, lane);
    } SEAM(4);
    if (IN(5)) REPS(5) { if (FAST_ATTN) phase5_fast(ka, lds); else phase5_ref(ka, gw, NGW, lane); } SEAM(5);
    if (IN(6)) REPS(6) {
        ge::Gemm g{(const char*)(ws + WS_OB), (const char*)(ws + WS_WA), 2048, 2048, 2048};
        ge::DenseSched S; S.init(T, 1024, G, blockIdx.x, 2048, 2048);
        EpiMerged E{(const bf16_t*)(ws + WS_SG), (bf16_t*)(ws + WS_MRG)};
        run_gemm<FAST_P6 != 0, false, false>(lds, g, S, E);
    } SEAM(6);
    if (IN(7)) REPS(7) {
        ge::Gemm g{(const char*)(ws + WS_MRG), (const char*)(ws + WS_WO), 2048, 2048, 2048};
        ge::DenseSched S; S.init(T, 1024, G, blockIdx.x, 2048, 2048);
        EpiWo E{(const float*)ka.in(I_X), (const float*)(ws + WS_ADA), (bf16_t*)(ws + WS_X1)};
        run_gemm<FAST_P7 != 0, false, false>(lds, g, S, E);
    } SEAM(7);
    if (IN(8)) REPS(8) { phase8(ka, lds, tid, wave, lane); } SEAM(8);
    if (IN(9)) REPS(9) {
        ge::MoeSched S; S.lda = 1024 * ME; S.ldb = 1024 * ME; S.nper = 2048; moe_setup(ka, lds, tid, S, 8, true);
        ge::Gemm g{(const char*)(ws + WS_H), (const char*)(ws + WS_WGU), 1024 * ME, 1024 * ME, 1024 * ME};
        EpiGU E{(const float*)ka.in(I_BGU), (unsigned char*)(ws + WS_ACT)};
        run_gemm<FAST_P9 != 0, true, MOE_FP8 != 0>(lds, g, S, E);
    } SEAM(9);
    if (IN(10)) REPS(10) {
        ge::MoeSched S; S.lda = 1024 * ME; S.ldb = 1024 * ME; S.nper = 1024; moe_setup(ka, lds, tid, S, 4, false);
        ge::Gemm g{(const char*)(ws + WS_ACT), (const char*)(ws + WS_WD), 1024 * ME, 1024 * ME, 1024 * ME};
        EpiDown E{(const float*)ka.in(I_BD), (const int*)(ws + WS_RFLAT), (const LAS int*)(lds + LDS_MOE) + 40, (unsigned char*)(ws + WS_Y)};
        run_gemm<FAST_P10 != 0, false, MOE_FP8 != 0>(lds, g, S, E);
    } SEAM(10);
    if (IN(11)) REPS(11) { phase11(ka, lds, tid, wave, lane); }
#undef IN
#undef SEAM
}

extern "C" void kernel_launch(void* const* d_in, const int* in_sizes, int n_in, void* d_out, int out_size, void* d_ws, size_t ws_size, hipStream_t stream) {
    static int grid = 0;
    if (grid == 0) {
        if (n_in != 23 || in_sizes[0] != T * D || out_size != T * D || ws_size < WS_END) {
            fprintf(stderr, "kernel_launch: unexpected problem: n_in %d in0 %d out %d ws %zu (need >= %zu)\n", n_in, n_in > 0 ? in_sizes[0] : -1, out_size, ws_size, (size_t)WS_END); grid = -1; return; }
        int dev = 0, cus = 0, per_cu = 0;
        if (hipGetDevice(&dev) != hipSuccess || hipDeviceGetAttribute(&cus, hipDeviceAttributeMultiprocessorCount, dev) != hipSuccess) { grid = -1; return; }
        if (hipFuncSetAttribute((const void*)fwd_kernel, hipFuncAttributeMaxDynamicSharedMemorySize, LDS_BYTES) != hipSuccess) { fprintf(stderr, "kernel_launch: hipFuncSetAttribute failed\n"); grid = -1; return; }
        if (hipOccupancyMaxActiveBlocksPerMultiprocessor(&per_cu, (const void*)fwd_kernel, NTHREADS, LDS_BYTES) != hipSuccess || per_cu < 1) {
            fprintf(stderr, "kernel_launch: occupancy query says %d blocks per CU\n", per_cu); (void)hipGetLastError(); grid = -1; return; }
        grid = cus;
    }
    if (grid < 0) return;
    if (MK_N_LAUNCHES != 1) (void)hipMemsetAsync((char*)d_ws + WS_CTL, 0, CTL_ZERO_BYTES, stream);
    Args a{};
    for (int i = 0; i < 23; ++i) a.in[i] = d_in[i];
    a.out = (float*)d_out; a.ws = (unsigned char*)d_ws;
    if (MK_N_LAUNCHES == 1) {
        a.ph_lo = 0; a.ph_hi = NPHASE; a.li = 0;
        hipLaunchKernelGGL(fwd_kernel, dim3(grid), dim3(NTHREADS), LDS_BYTES, stream, a);
    } else {
        for (int p = 0; p < NPHASE; ++p) { a.ph_lo = p; a.ph_hi = p + 1; a.li = p; hipLaunchKernelGGL(fwd_kernel, dim3(grid), dim3(NTHREADS), LDS_BYTES, stream, a); }
    }
    const hipError_t le = hipPeekAtLastError();
    if (le != hipSuccess) fprintf(stderr, "kernel_launch: launch failed: %s\n", hipGetErrorName(le));
}
```
